# Optimizing an MI355X kernel written in HIP

```python
import math
import jax, jax.numpy as jnp
from jax import lax
import numpy as np

D_MODEL = 1024
BATCH = 4
SEQ = 8192
DEPTH = 1

N_Q_HEADS = 8
N_KV_HEADS = 4
GQA_GROUP = N_Q_HEADS // N_KV_HEADS
HEAD_DIM = 128
WINDOW = 128
BLOCK = 128
N_HALO = -(-WINDOW // BLOCK)
NEG_INF = -1e30
CONV_CH = D_MODEL
CONV_WIDTH = 31
CONV_PAD = (CONV_WIDTH - 1) // 2
CONV_IN_W = 2 * CONV_CH
Q_W = N_Q_HEADS * HEAD_DIM
KV_W = N_KV_HEADS * HEAD_DIM
GATE_W = 2 * D_MODEL
Q_OFF = CONV_IN_W
K_OFF = Q_OFF + Q_W
V_OFF = K_OFF + KV_W
G_OFF = V_OFF + KV_W
IN_WIDTH = G_OFF + GATE_W
N_GROUPS = 4
EXPERTS_PER_GROUP = 8
N_EXPERTS = N_GROUPS * EXPERTS_PER_GROUP
TOP_K = 2
EXPERT_HIDDEN = D_MODEL // 4
LN_EPS = 1e-5
DEEPNORM_ALPHA = (2.0 * DEPTH) ** 0.25
DEEPNORM_BETA = (8.0 * DEPTH) ** -0.25

kernel_name = "hybrid_conv_swa_hmoe_encoder"


def layer_norm(x, g, b):
    xf = x.astype(jnp.float32)
    mu = xf.mean(-1, keepdims=True)
    var = jnp.square(xf - mu).mean(-1, keepdims=True)
    return ((xf - mu) * lax.rsqrt(var + LN_EPS) * g + b).astype(x.dtype)


def conformer_conv(u, w_dw, b_dw, ln_g, ln_b, w_proj):
    a, gate = jnp.split(u, 2, axis=-1)
    h = a * jax.nn.sigmoid(gate)
    h = lax.conv_general_dilated(
        h, w_dw[:, None, :].astype(h.dtype), window_strides=(1,),
        padding=((CONV_PAD, CONV_PAD),),
        dimension_numbers=("NWC", "WIO", "NWC"),
        feature_group_count=CONV_CH) + b_dw
    h = jax.nn.silu(layer_norm(h, ln_g, ln_b))
    return h @ w_proj


def windowed_gqa(q, k, v, sink, slopes):
    B, S = q.shape[0], q.shape[1]
    nb = S // BLOCK
    span = (2 * N_HALO + 1) * BLOCK
    qb = q.reshape(B, nb, BLOCK, N_KV_HEADS, GQA_GROUP, HEAD_DIM)

    def band(t):
        tp = jnp.pad(t, ((0, 0), (N_HALO * BLOCK, N_HALO * BLOCK), (0, 0), (0, 0)))
        tp = tp.reshape(B, nb + 2 * N_HALO, BLOCK, N_KV_HEADS, HEAD_DIM)
        return jnp.concatenate([tp[:, o:o + nb] for o in range(2 * N_HALO + 1)], axis=2)

    kb, vb = band(k), band(v)
    s = jnp.einsum("bnqhgd,bnshd->bnhgqs", qb, kb,
                   preferred_element_type=jnp.float32) * (HEAD_DIM ** -0.5)
    qi = jnp.arange(BLOCK)[:, None]
    kj = jnp.arange(span)[None, :]
    rel = kj - N_HALO * BLOCK - qi
    kpos = jnp.arange(nb)[:, None, None] * BLOCK - N_HALO * BLOCK + kj
    valid = (jnp.abs(rel) <= WINDOW)[None] & (kpos >= 0) & (kpos < S)
    dist = jnp.abs(rel).astype(jnp.float32)
    alibi = -slopes.reshape(N_KV_HEADS, GQA_GROUP)[:, :, None, None] * dist
    s = jnp.where(valid[None, :, None, None], s + alibi, NEG_INF)
    sk = sink.astype(jnp.float32).reshape(N_KV_HEADS, GQA_GROUP)[:, :, None, None]
    m = jnp.maximum(s.max(-1, keepdims=True), sk)
    p = jnp.exp(s - m)
    p = p / (p.sum(-1, keepdims=True) + jnp.exp(sk - m))
    o = jnp.einsum("bnhgqs,bnshd->bnqhgd", p.astype(v.dtype), vb)
    return o.reshape(B, S, Q_W).astype(q.dtype)


def hierarchical_moe(x, w_rg, b_rg, w_re, b_re, w_gate_up, w_down):
    B, S, D = x.shape
    t = x.reshape(B * S, D)
    g_logits = (t @ w_rg + b_rg).astype(jnp.float32)
    g_prob = jax.nn.softmax(g_logits, axis=-1)
    g_idx = jnp.argmax(g_logits, axis=-1)
    g_w = jnp.take_along_axis(g_prob, g_idx[:, None], axis=-1)
    e_logits = (t @ w_re + b_re).astype(jnp.float32).reshape(-1, N_GROUPS, EXPERTS_PER_GROUP)
    e_in = jnp.take_along_axis(e_logits, g_idx[:, None, None], axis=1)[:, 0]
    e_prob = jax.nn.softmax(e_in, axis=-1)
    top_w, top_i = lax.top_k(e_prob, TOP_K)
    top_w = top_w / top_w.sum(-1, keepdims=True)
    expert_id = g_idx[:, None] * EXPERTS_PER_GROUP + top_i
    weight = g_w * top_w
    comb = (jax.nn.one_hot(expert_id, N_EXPERTS, dtype=jnp.float32) * weight[..., None]).sum(1)
    out = jnp.zeros((B * S, D), jnp.float32)
    for e in range(N_EXPERTS):
        hg, hu = jnp.split(t @ w_gate_up[e], 2, axis=-1)
        out = out + comb[:, e:e + 1] * ((jax.nn.silu(hg) * hu) @ w_down[e])
    return out.astype(x.dtype).reshape(B, S, D)


def setup_inputs(seed: int = 0) -> dict:
    key = jax.random.key(seed)
    ks = jax.random.split(key, 24)
    L, D = DEPTH, D_MODEL
    f32 = jnp.float32

    def nrm(k, shape, scale):
        return jax.random.normal(k, shape, f32) * scale

    x = nrm(ks[0], (BATCH, SEQ, D), 1.0)
    w_in = nrm(ks[1], (L, D, IN_WIDTH), D ** -0.5)
    w_in = w_in.at[:, :, V_OFF:V_OFF + KV_W].multiply(DEEPNORM_BETA)
    return {
        "x": x,
        "w_in": w_in,
        "b_gate": nrm(ks[2], (L, GATE_W), 0.02),
        "w_dw": nrm(ks[3], (L, CONV_WIDTH, CONV_CH), CONV_WIDTH ** -0.5),
        "b_dw": nrm(ks[4], (L, CONV_CH), 0.02),
        "conv_ln_g": 1.0 + nrm(ks[5], (L, CONV_CH), 0.02),
        "conv_ln_b": nrm(ks[6], (L, CONV_CH), 0.02),
        "w_conv_proj": nrm(ks[7], (L, CONV_CH, D), CONV_CH ** -0.5),
        "attn_sink": nrm(ks[8], (L, N_Q_HEADS), 0.5),
        "w_attn_proj": nrm(ks[9], (L, Q_W, D), Q_W ** -0.5),
        "w_out": nrm(ks[10], (L, D, D), D ** -0.5 * DEEPNORM_BETA),
        "ln1_g": 1.0 + nrm(ks[11], (L, D), 0.02),
        "ln1_b": nrm(ks[12], (L, D), 0.02),
        "w_router_group": nrm(ks[13], (L, D, N_GROUPS), D ** -0.5),
        "b_router_group": nrm(ks[14], (L, N_GROUPS), 0.01),
        "w_router_expert": nrm(ks[15], (L, D, N_EXPERTS), D ** -0.5),
        "b_router_expert": nrm(ks[16], (L, N_EXPERTS), 0.01),
        "w_gate_up": nrm(ks[17], (L, N_EXPERTS, D, 2 * EXPERT_HIDDEN), D ** -0.5),
        "w_down": nrm(ks[18], (L, N_EXPERTS, EXPERT_HIDDEN, D), EXPERT_HIDDEN ** -0.5 * DEEPNORM_BETA),
        "ln2_g": 1.0 + nrm(ks[19], (L, D), 0.02),
        "ln2_b": nrm(ks[20], (L, D), 0.02),
    }


def reference(x, w_in, b_gate, w_dw, b_dw, conv_ln_g, conv_ln_b, w_conv_proj, attn_sink,
              w_attn_proj, w_out, ln1_g, ln1_b, w_router_group, b_router_group,
              w_router_expert, b_router_expert, w_gate_up, w_down, ln2_g, ln2_b):
    B, S, _ = x.shape
    slopes = jnp.exp2(-8.0 * jnp.arange(1, N_Q_HEADS + 1, dtype=jnp.float32) / N_Q_HEADS)
    for l in range(DEPTH):
        proj = x @ w_in[l]
        conv_u = proj[..., :Q_OFF]
        q = proj[..., Q_OFF:K_OFF].reshape(B, S, N_Q_HEADS, HEAD_DIM)
        k = proj[..., K_OFF:V_OFF].reshape(B, S, N_KV_HEADS, HEAD_DIM)
        v = proj[..., V_OFF:G_OFF].reshape(B, S, N_KV_HEADS, HEAD_DIM)
        gates = jax.nn.sigmoid(proj[..., G_OFF:] + b_gate[l])
        g_conv, g_attn = gates[..., :D_MODEL], gates[..., D_MODEL:]
        conv_out = conformer_conv(conv_u, w_dw[l], b_dw[l], conv_ln_g[l], conv_ln_b[l], w_conv_proj[l])
        attn_out = windowed_gqa(q, k, v, attn_sink[l], slopes) @ w_attn_proj[l]
        mixed = (g_conv * conv_out + g_attn * attn_out) @ w_out[l]
        x = layer_norm(DEEPNORM_ALPHA * x + mixed, ln1_g[l], ln1_b[l])
        moe = hierarchical_moe(x, w_router_group[l], b_router_group[l], w_router_expert[l],
                               b_router_expert[l], w_gate_up[l], w_down[l])
        x = layer_norm(DEEPNORM_ALPHA * x + moe, ln2_g[l], ln2_b[l])
    return x
```

```cpp
#include <hip/hip_runtime.h>
#include <hip/hip_cooperative_groups.h>
#include <cstdio>
#include <cstdint>
namespace cg = cooperative_groups;

#define LAS __attribute__((address_space(3)))
typedef unsigned short bf16_t;
typedef short bf16x8 __attribute__((ext_vector_type(8)));
typedef short s16x4 __attribute__((ext_vector_type(4)));
typedef float f32x2 __attribute__((ext_vector_type(2)));
typedef float f32x4 __attribute__((ext_vector_type(4)));
typedef float f32x8 __attribute__((ext_vector_type(8)));
typedef float f32x16 __attribute__((ext_vector_type(16)));
typedef unsigned u32x2 __attribute__((ext_vector_type(2)));
typedef unsigned u32x4 __attribute__((ext_vector_type(4)));
typedef __bf16 bf16x2_t __attribute__((ext_vector_type(2)));

constexpr int D = 1024, NBATCH = 4, SEQ = 8192, M = NBATCH * SEQ;
constexpr int INW = 6144;
constexpr int NEXP = 32, EH = 256;
constexpr int CAP = 32768;
constexpr float LN_EPS = 1e-5f;
constexpr float ALPHA = 1.189207115002721f;
constexpr float LOG2E = 1.4426950408889634f;
constexpr int NTHREADS = 512;
constexpr int NPH = 9;

constexpr size_t MiB = 1u << 20;
constexpr size_t WS_CTL = 0;
constexpr size_t WS_WIN = 2 * MiB;
constexpr size_t WS_WC = 14 * MiB, WS_WA = 16 * MiB, WS_WO = 18 * MiB;
constexpr size_t WS_WGU = 20 * MiB;
constexpr size_t WS_WD = 52 * MiB;
constexpr size_t WS_WR = 68 * MiB;
constexpr size_t WS_TOKW = 69 * MiB;
constexpr size_t WS_STAT = 70 * MiB;
constexpr size_t WS_LIST = 71 * MiB;
constexpr size_t WS_A = 80 * MiB;
constexpr size_t WS_B = 144 * MiB;
constexpr size_t WS_C = 209 * MiB;
constexpr size_t WS_D = 273 * MiB;
constexpr size_t WS_E = 337 * MiB;
constexpr size_t WS_END = 465 * MiB;
constexpr int HPAD = 15, HROWS = SEQ + 2 * HPAD;
constexpr int CW_CNT = 0;

constexpr int LDS_BYTES = 147456;
constexpr int LDS_PRE = 140288;

__device__ __forceinline__ unsigned cvtpk(float lo, float hi) { f32x2 v = {lo, hi}; bf16x2_t b = __builtin_convertvector(v, bf16x2_t); return __builtin_bit_cast(unsigned, b); }
__device__ __forceinline__ float bf2f(unsigned h) { return __uint_as_float(h << 16); }
__device__ __forceinline__ float bflo(unsigned w) { return __uint_as_float(w << 16); }
__device__ __forceinline__ float bfhi(unsigned w) { return __uint_as_float(w & 0xffff0000u); }
__device__ __forceinline__ float sigmoidf_(float x) { return __builtin_amdgcn_rcpf(1.0f + __builtin_amdgcn_exp2f(-x * LOG2E)); }
__device__ __forceinline__ float wave_sum(float v) {
#pragma unroll
    for (int o = 1; o < 64; o <<= 1) v += __shfl_xor(v, o);
    return v;
}

struct Params {
    const float* in[21];
    float* out;
    unsigned char* ws;
    int ph_lo, ph_hi;
};

namespace pg8 {
constexpr int BM = 256, BK = 64, HALF = 128, HTB = HALF * BK * 2, STAGE_BYTES = 8 * HTB, NXCD = 8, WGM = 8;
__host__ __device__ __forceinline__ int lds_byte(int r, int c) { const int st = (r >> 4) * 2 + (c >> 5), rr = r & 15, cc = c & 31, ob = rr * 64 + cc * 2; return st * 1024 + (ob ^ (((ob >> 9) & 1) << 5)); }
__host__ __device__ __forceinline__ void stage_rc(int b, int& R, int& C) { const int st = b / 1024, sb = b % 1024, swz = sb ^ (((sb >> 9) & 1) << 5); R = (st >> 1) * 16 + swz / 64; C = (st & 1) * 32 + (swz % 64) / 2; }
__host__ __device__ __forceinline__ int perm32(int rho) { const int n = rho >> 4, i = rho & 15; return 8 * (i >> 2) + 4 * n + (i & 3); }

struct Unit { int pm, pn, ex, lb, nv; };

__device__ __forceinline__ bool static_tile(int L, int nM, int nN, int& pm, int& pn) {
    const int nwg = nM * nN; if (L >= nwg) return false;
    int wgid = L; { const int q = nwg / NXCD, r = nwg % NXCD, xcd = wgid % NXCD, off = wgid / NXCD; wgid = (xcd < r ? xcd * (q + 1) : r * (q + 1) + (xcd - r) * q) + off; }
    const int nig = WGM * nN, gid = wgid / nig, fm = gid * WGM, gsz = (nM - fm) < WGM ? (nM - fm) : WGM;
    pm = fm + ((wgid % nig) % gsz); pn = (wgid % nig) / gsz; return true;
}

template <class P, bool ALIGN_EPI>
__device__ __forceinline__ void gemm_phase(LAS unsigned char* lds, const P& p) {
    constexpr int K = P::K; constexpr bool GATHER = P::GATHER;
    const int tid = threadIdx.x, wid = __builtin_amdgcn_readfirstlane(tid >> 6), lane = tid & 63, wr = wid >> 2, wc = wid & 3, fr = lane & 15, fq = lane >> 4;
    constexpr int nt = K / BK;
    unsigned voffB[2]; int Rr[2], Cc[2];
#pragma unroll
    for (int i = 0; i < 2; ++i) { int R, C; stage_rc(tid * 16 + i * 8192, R, C); const int Rb = (R & ~31) + perm32(R & 31); voffB[i] = (unsigned)(Rb * K + C) * 2u; Rr[i] = R; Cc[i] = C; }
    constexpr size_t kstep = (size_t)(BK * 2);
    constexpr size_t hstep = (size_t)HALF * K * 2;
    const unsigned ldsw = (unsigned)wid * 1024u;
    const int aoff = lds_byte(wr * 64 + fr, fq * 8), boff = lds_byte(wc * 32 + fr, fq * 8);
#define PG8_SA(b, h) (((b) * 2 + (h)) * HTB)
#define PG8_SB(b, h) ((4 + (b) * 2 + (h)) * HTB)
#define PG8_GL(src, dstoff) __builtin_amdgcn_global_load_lds((const unsigned*)(src), (LAS unsigned*)(lds + (dstoff)), 16, 0, 0)
#define PG8_STAGEB(bufoff, gbase) do { PG8_GL((const char*)(gbase) + voffB[0], (bufoff) + ldsw); PG8_GL((const char*)(gbase) + voffB[1], (bufoff) + ldsw + 8192); } while (0)
#define PG8_STAGEA(bufoff, gbase, v0, v1) do { PG8_GL((const char*)(gbase) + (v0), (bufoff) + ldsw); PG8_GL((const char*)(gbase) + (v1), (bufoff) + ldsw + 8192); } while (0)
#define PG8_LDA(dst, b, h) do { _Pragma("unroll") for (int m = 0; m < 4; ++m) _Pragma("unroll") for (int k = 0; k < 2; ++k) dst[m][k] = *(const LAS bf16x8*)(lds + PG8_SA(b, h) + aoff + m * 2048 + k * 1024); } while (0)
#define PG8_LDB(dst, b, h) do { _Pragma("unroll") for (int n = 0; n < 2; ++n) _Pragma("unroll") for (int k = 0; k < 2; ++k) dst[n][k] = *(const LAS bf16x8*)(lds + PG8_SB(b, h) + boff + n * 2048 + k * 1024); } while (0)
#define PG8_MMA(ai, bj, At, Bt) do { __builtin_amdgcn_s_setprio(1); _Pragma("unroll") for (int m = 0; m < 4; ++m) _Pragma("unroll") for (int n = 0; n < 2; ++n) _Pragma("unroll") for (int k = 0; k < 2; ++k) \
        acc[ai][bj][m][n] = __builtin_amdgcn_mfma_f32_16x16x32_bf16(Bt[n][k], At[m][k], acc[ai][bj][m][n], 0, 0, 0); __builtin_amdgcn_s_setprio(0); } while (0)
#define PG8_WAIT_V(n) asm volatile("s_waitcnt vmcnt(" #n ")" ::: "memory")
#define PG8_WAIT_L(n) asm volatile("s_waitcnt lgkmcnt(" #n ")" ::: "memory")
#define PG8_BAR __builtin_amdgcn_s_barrier()
#define PG8_SCHED __builtin_amdgcn_sched_barrier(0)
    Unit cur, nxt; int ui = 0;
    if (!p.next(0, cur)) return;
    f32x4 acc[2][2][4][2];
#pragma unroll
    for (int a = 0; a < 2; ++a)
#pragma unroll
        for (int b = 0; b < 2; ++b)
#pragma unroll
            for (int m = 0; m < 4; ++m)
#pragma unroll
                for (int n = 0; n < 2; ++n) acc[a][b][m][n] = (f32x4){0.f, 0.f, 0.f, 0.f};
    bf16x8 At[4][2], B0[2][2], B1[2][2];
    const char* cA = p.a_base(cur); const char* cB = p.b_base(cur);
    unsigned c00, c01, c10, c11;
    if constexpr (GATHER) { c00 = p.a_off(cur, Rr[0], Cc[0]); c01 = p.a_off(cur, Rr[1], Cc[1]); c10 = p.a_off(cur, Rr[0] + HALF, Cc[0]); c11 = p.a_off(cur, Rr[1] + HALF, Cc[1]); }
    else { c00 = (unsigned)(Rr[0] * K + Cc[0]) * 2u; c01 = (unsigned)(Rr[1] * K + Cc[1]) * 2u; c10 = c00 + (unsigned)hstep; c11 = c01 + (unsigned)hstep; }
    PG8_STAGEB(PG8_SB(0, 0), cB); PG8_STAGEB(PG8_SB(0, 1), cB + hstep); PG8_STAGEA(PG8_SA(0, 0), cA, c00, c01); PG8_STAGEA(PG8_SA(0, 1), cA, c10, c11);
    if (wr == 1) PG8_BAR;
    PG8_WAIT_V(2); PG8_BAR;
    PG8_STAGEB(PG8_SB(1, 0), cB + kstep); PG8_STAGEA(PG8_SA(1, 0), cA + kstep, c00, c01); PG8_STAGEB(PG8_SB(1, 1), cB + hstep + kstep);
    PG8_WAIT_V(6); PG8_BAR;
    for (;;) {
        const bool has_next = p.next(ui + 1, nxt);
        const char* nA = has_next ? p.a_base(nxt) : cA; const char* nB = has_next ? p.b_base(nxt) : cB;
        unsigned n00 = c00, n01 = c01, n10 = c10, n11 = c11;
        if constexpr (GATHER) { if (has_next) { n00 = p.a_off(nxt, Rr[0], Cc[0]); n01 = p.a_off(nxt, Rr[1], Cc[1]); n10 = p.a_off(nxt, Rr[0] + HALF, Cc[0]); n11 = p.a_off(nxt, Rr[1] + HALF, Cc[1]); } }
#pragma unroll 1
        for (int t = 0; t < nt; t += 2) {
            const bool last = (t == nt - 2);
            const char* a1 = cA + (size_t)(t + 1) * kstep;
            const char* a2 = last ? nA : cA + (size_t)(t + 2) * kstep; const char* b2 = last ? nB : cB + (size_t)(t + 2) * kstep;
            const char* a3 = a2 + kstep; const char* b3 = b2 + kstep;
            unsigned x00 = c00, x01 = c01, x10 = c10, x11 = c11;
            if constexpr (GATHER) { if (last) { x00 = n00; x01 = n01; x10 = n10; x11 = n11; } }
            PG8_LDB(B0, 0, 0); PG8_LDB(B1, 0, 1); PG8_SCHED; PG8_LDA(At, 0, 0); PG8_STAGEA(PG8_SA(1, 1), a1, c10, c11);
            PG8_WAIT_V(8); PG8_WAIT_L(0); PG8_BAR; PG8_MMA(0, 0, At, B0); PG8_MMA(0, 1, At, B1); PG8_BAR; PG8_SCHED;
            PG8_LDA(At, 0, 1); PG8_STAGEB(PG8_SB(0, 0), b2); PG8_STAGEB(PG8_SB(0, 1), b2 + hstep); PG8_STAGEA(PG8_SA(0, 0), a2, x00, x01);
            PG8_WAIT_V(8); PG8_WAIT_L(0); PG8_BAR; PG8_MMA(1, 0, At, B0); PG8_MMA(1, 1, At, B1); PG8_BAR; PG8_SCHED;
            PG8_LDB(B0, 1, 0); PG8_LDB(B1, 1, 1); PG8_SCHED; PG8_LDA(At, 1, 0); PG8_STAGEA(PG8_SA(0, 1), a2, x10, x11);
            PG8_WAIT_V(8); PG8_WAIT_L(0); PG8_BAR; PG8_MMA(0, 0, At, B0); PG8_MMA(0, 1, At, B1); PG8_BAR; PG8_SCHED;
            PG8_LDA(At, 1, 1); PG8_STAGEB(PG8_SB(1, 0), b3); PG8_STAGEB(PG8_SB(1, 1), b3 + hstep); PG8_STAGEA(PG8_SA(1, 0), a3, x00, x01);
            PG8_WAIT_V(8); PG8_WAIT_L(0); PG8_BAR; PG8_MMA(1, 0, At, B0); PG8_MMA(1, 1, At, B1); PG8_BAR; PG8_SCHED;
        }
        if constexpr (ALIGN_EPI) { if (wr == 0) PG8_BAR; }
        const bool keep = p.epi(acc, cur, wr, wc, fr, fq);
        if (!has_next) break;
        if (!keep) {
#pragma unroll
            for (int a = 0; a < 2; ++a)
#pragma unroll
                for (int b = 0; b < 2; ++b)
#pragma unroll
                    for (int m = 0; m < 4; ++m)
#pragma unroll
                        for (int n = 0; n < 2; ++n) acc[a][b][m][n] = (f32x4){0.f, 0.f, 0.f, 0.f};
        }
        cur = nxt; cA = nA; cB = nB; c00 = n00; c01 = n01; c10 = n10; c11 = n11; ++ui;
        if constexpr (ALIGN_EPI) { if (wr == 1) PG8_BAR; }
    }
    PG8_WAIT_V(0);
    if constexpr (!ALIGN_EPI) { if (wr == 0) PG8_BAR; }
    PG8_BAR;
#undef PG8_SA
#undef PG8_SB
#undef PG8_GL
#undef PG8_STAGEA
#undef PG8_STAGEB
#undef PG8_LDA
#undef PG8_LDB
#undef PG8_MMA
#undef PG8_WAIT_V
#undef PG8_WAIT_L
#undef PG8_BAR
#undef PG8_SCHED
}
}
using pg8::Unit;

__device__ __forceinline__ void st16_bf16(bf16_t* p, f32x4 v0, f32x4 v1) {
    u32x4 w; w.x = cvtpk(v0[0], v0[1]); w.y = cvtpk(v0[2], v0[3]); w.z = cvtpk(v1[0], v1[1]); w.w = cvtpk(v1[2], v1[3]);
    *(u32x4*)p = w;
}
__device__ __forceinline__ void ld8_bf16(const bf16_t* p, f32x4& v0, f32x4& v1) {
    const u32x4 w = *(const u32x4*)p;
    v0 = (f32x4){bflo(w.x), bfhi(w.x), bflo(w.y), bfhi(w.y)}; v1 = (f32x4){bflo(w.z), bfhi(w.z), bflo(w.w), bfhi(w.w)};
}

struct ProbIn {
    static constexpr int K = 1024; static constexpr bool GATHER = false;
    unsigned char* ws; int G, c; const float* b_gate;
    __device__ __forceinline__ bool next(int i, Unit& u) const { u.ex = 0; u.lb = 0; u.nv = 256; return pg8::static_tile(i * G + c, M / 256, INW / 256, u.pm, u.pn); }
    __device__ __forceinline__ const char* a_base(const Unit& u) const { return (const char*)(ws + WS_A) + (size_t)u.pm * 256 * K * 2; }
    __device__ __forceinline__ const char* b_base(const Unit& u) const { return (const char*)(ws + WS_WIN) + (size_t)u.pn * 256 * K * 2; }
    __device__ __forceinline__ bool epi(f32x4 (&acc)[2][2][4][2], const Unit& u, int wr, int wc, int fr, int fq) const {
        const int row0 = u.pm * 256 + wr * 64 + fr, cw = wc * 32 + 8 * fq;
        if (u.pn < 8) {
#pragma unroll
            for (int ai = 0; ai < 2; ++ai)
#pragma unroll
                for (int m = 0; m < 4; ++m) {
                    f32x4 h0, h1;
#pragma unroll
                    for (int e = 0; e < 4; ++e) { h0[e] = acc[ai][0][m][0][e] * sigmoidf_(acc[ai][1][m][0][e]); h1[e] = acc[ai][0][m][1][e] * sigmoidf_(acc[ai][1][m][1][e]); }
                    st16_bf16((bf16_t*)(ws + WS_B) + (size_t)(row0 + ai * 128 + m * 16 + 2 * HPAD * (u.pm >> 5) + HPAD) * 1024 + u.pn * 128 + cw, h0, h1);
                }
        } else if (u.pn < 16) {
            size_t boff; int ld, colt;
            if (u.pn < 12) { boff = WS_C; ld = 1024; colt = (u.pn - 8) * 256; } else if (u.pn < 14) { boff = WS_D; ld = 512; colt = (u.pn - 12) * 256; } else { boff = WS_D + (size_t)M * 512 * 2; ld = 512; colt = (u.pn - 14) * 256; }
            bf16_t* base = (bf16_t*)(ws + boff);
#pragma unroll
            for (int ai = 0; ai < 2; ++ai)
#pragma unroll
                for (int m = 0; m < 4; ++m)
#pragma unroll
                    for (int bj = 0; bj < 2; ++bj) st16_bf16(base + (size_t)(row0 + ai * 128 + m * 16) * ld + colt + bj * 128 + cw, acc[ai][bj][m][0], acc[ai][bj][m][1]);
        } else {
            const int colt = (u.pn - 16) * 256;
            f32x4 bv[2][2];
#pragma unroll
            for (int bj = 0; bj < 2; ++bj)
#pragma unroll
                for (int n = 0; n < 2; ++n) bv[bj][n] = *(const f32x4*)(b_gate + colt + bj * 128 + cw + 4 * n);
#pragma unroll
            for (int ai = 0; ai < 2; ++ai)
#pragma unroll
                for (int m = 0; m < 4; ++m)
#pragma unroll
                    for (int bj = 0; bj < 2; ++bj) {
                        f32x4 v0 = acc[ai][bj][m][0] + bv[bj][0], v1 = acc[ai][bj][m][1] + bv[bj][1];
#pragma unroll
                        for (int e = 0; e < 4; ++e) { v0[e] = sigmoidf_(v0[e]); v1[e] = sigmoidf_(v1[e]); }
                        st16_bf16((bf16_t*)(ws + WS_E) + (size_t)(row0 + ai * 128 + m * 16) * 2048 + colt + bj * 128 + cw, v0, v1);
                    }
        }
        return false;
    }
};

struct ProbMix {
    static constexpr int K = 1024; static constexpr bool GATHER = false;
    unsigned char* ws; int G, c;
    __device__ __forceinline__ bool next(int i, Unit& u) const { u.ex = i & 1; u.lb = 0; u.nv = 256; return pg8::static_tile((i >> 1) * G + c, M / 256, D / 256, u.pm, u.pn); }
    __device__ __forceinline__ const char* a_base(const Unit& u) const { return (const char*)(ws + (u.ex ? WS_C : WS_A)) + (size_t)u.pm * 256 * K * 2; }
    __device__ __forceinline__ const char* b_base(const Unit& u) const { return (const char*)(ws + (u.ex ? WS_WA : WS_WC)) + (size_t)u.pn * 256 * K * 2; }
    __device__ __forceinline__ bool epi(f32x4 (&acc)[2][2][4][2], const Unit& u, int wr, int wc, int fr, int fq) const {
        const int row0 = u.pm * 256 + wr * 64 + fr, col0 = u.pn * 256 + wc * 32 + 8 * fq;
        const bf16_t* Gt = (const bf16_t*)(ws + WS_E); bf16_t* Mx = (bf16_t*)(ws + WS_B);
        if (u.ex == 0) {
#pragma unroll
            for (int ai = 0; ai < 2; ++ai)
#pragma unroll
                for (int m = 0; m < 4; ++m)
#pragma unroll
                    for (int bj = 0; bj < 2; ++bj) {
                        const bf16_t* gp = Gt + (size_t)(row0 + ai * 128 + m * 16) * 2048 + col0 + bj * 128;
                        f32x4 c0, c1, a0, a1; ld8_bf16(gp, c0, c1); ld8_bf16(gp + 1024, a0, a1);
#pragma unroll
                        for (int e = 0; e < 4; ++e) { acc[ai][bj][m][0][e] *= c0[e] * __builtin_amdgcn_rcpf(a0[e]); acc[ai][bj][m][1][e] *= c1[e] * __builtin_amdgcn_rcpf(a1[e]); }
                    }
            return true;
        }
#pragma unroll
        for (int ai = 0; ai < 2; ++ai)
#pragma unroll
            for (int m = 0; m < 4; ++m)
#pragma unroll
                for (int bj = 0; bj < 2; ++bj) {
                    const size_t off = (size_t)(row0 + ai * 128 + m * 16);
                    f32x4 a0, a1; ld8_bf16(Gt + off * 2048 + 1024 + col0 + bj * 128, a0, a1);
                    st16_bf16(Mx + off * 1024 + col0 + bj * 128, acc[ai][bj][m][0] * a0, acc[ai][bj][m][1] * a1);
                }
        return false;
    }
};

struct ProbOut {
    static constexpr int K = 1024; static constexpr bool GATHER = false;
    const bf16_t *A, *Bt; int G, c;
    const float* x; float* y;
    __device__ __forceinline__ bool next(int i, Unit& u) const { u.ex = 0; u.lb = 0; u.nv = 256; return pg8::static_tile(i * G + c, M / 256, D / 256, u.pm, u.pn); }
    __device__ __forceinline__ const char* a_base(const Unit& u) const { return (const char*)(A + (size_t)u.pm * 256 * K); }
    __device__ __forceinline__ const char* b_base(const Unit& u) const { return (const char*)(Bt + (size_t)u.pn * 256 * K); }
    __device__ __forceinline__ bool epi(f32x4 (&acc)[2][2][4][2], const Unit& u, int wr, int wc, int fr, int fq) const {
        const int row0 = u.pm * 256 + wr * 64 + fr, col0 = u.pn * 256 + wc * 32 + 8 * fq;
#pragma unroll
        for (int ai = 0; ai < 2; ++ai)
#pragma unroll
            for (int m = 0; m < 4; ++m)
#pragma unroll
                for (int bj = 0; bj < 2; ++bj) {
                    const size_t off = (size_t)(row0 + ai * 128 + m * 16) * 1024 + col0 + bj * 128;
                    const f32x4 x0 = *(const f32x4*)(x + off), x1 = *(const f32x4*)(x + off + 4);
                    *(f32x4*)(y + off) = x0 * ALPHA + acc[ai][bj][m][0]; *(f32x4*)(y + off + 4) = x1 * ALPHA + acc[ai][bj][m][1];
                }
        return false;
    }
};

template <int NCOL>
__device__ __forceinline__ bool moe_next(const LAS int* pre, int L, Unit& u) {
    const int total = pre[NEXP] * NCOL; if (L >= total) return false;
    const int rtg = L / NCOL; u.pn = L - rtg * NCOL; int e = 0;
#pragma unroll 1
    for (int j = 1; j < NEXP; ++j) e += (pre[j] <= rtg) ? 1 : 0;
    e = __builtin_amdgcn_readfirstlane(e);
    const int rtl = rtg - pre[e], ne = pre[33 + e];
    u.pm = __builtin_amdgcn_readfirstlane(rtg); u.ex = e; u.lb = __builtin_amdgcn_readfirstlane(e * CAP + rtl * 256); u.nv = __builtin_amdgcn_readfirstlane(min(256, ne - rtl * 256));
    u.pn = __builtin_amdgcn_readfirstlane(u.pn);
    return true;
}
struct ProbMoe1 {
    static constexpr int K = 1024; static constexpr bool GATHER = true;
    const bf16_t *A, *Bt; int G, c; const LAS int* pre; const int* list; bf16_t* Hm;
    __device__ __forceinline__ bool next(int i, Unit& u) const { return moe_next<2>(pre, i * G + c, u); }
    __device__ __forceinline__ const char* a_base(const Unit&) const { return (const char*)A; }
    __device__ __forceinline__ unsigned a_off(const Unit& u, int r, int cc) const { const int rr = r < u.nv ? r : u.nv - 1; const int ent = list[u.lb + rr]; return (unsigned)((ent >> 1) * K + cc) * 2u; }
    __device__ __forceinline__ const char* b_base(const Unit& u) const { return (const char*)(Bt + ((size_t)u.ex * 512 + (size_t)u.pn * 256) * K); }
    __device__ __forceinline__ bool epi(f32x4 (&acc)[2][2][4][2], const Unit& u, int wr, int wc, int fr, int fq) const {
        const int row0 = u.pm * 256 + wr * 64 + fr, cw = u.pn * 128 + wc * 32 + 8 * fq;
#pragma unroll
        for (int ai = 0; ai < 2; ++ai)
#pragma unroll
            for (int m = 0; m < 4; ++m) {
                f32x4 h0, h1;
#pragma unroll
                for (int e = 0; e < 4; ++e) { const float g0 = acc[ai][0][m][0][e], g1 = acc[ai][0][m][1][e]; h0[e] = g0 * sigmoidf_(g0) * acc[ai][1][m][0][e]; h1[e] = g1 * sigmoidf_(g1) * acc[ai][1][m][1][e]; }
                st16_bf16(Hm + (size_t)(row0 + ai * 128 + m * 16) * EH + cw, h0, h1);
            }
        return false;
    }
};
struct ProbMoe2 {
    static constexpr int K = 256; static constexpr bool GATHER = false;
    const bf16_t *A, *Bt; int G, c; const LAS int* pre; const int* list; const float* tokw; bf16_t *S0, *S1;
    __device__ __forceinline__ bool next(int i, Unit& u) const { return moe_next<4>(pre, i * G + c, u); }
    __device__ __forceinline__ const char* a_base(const Unit& u) const { return (const char*)(A + (size_t)u.pm * 256 * K); }
    __device__ __forceinline__ const char* b_base(const Unit& u) const { return (const char*)(Bt + ((size_t)u.ex * 1024 + (size_t)u.pn * 256) * K); }
    __device__ __forceinline__ bool epi(f32x4 (&acc)[2][2][4][2], const Unit& u, int wr, int wc, int fr, int fq) const {
        const int col0 = u.pn * 256 + wc * 32 + 8 * fq;
#pragma unroll
        for (int ai = 0; ai < 2; ++ai)
#pragma unroll
            for (int m = 0; m < 4; ++m) {
                const int rl = ai * 128 + wr * 64 + m * 16 + fr;
                if (rl < u.nv) {
                    const int ent = list[u.lb + rl]; const float w = tokw[ent];
                    bf16_t* dst = ((ent & 1) ? S1 : S0) + (size_t)(ent >> 1) * 1024 + col0;
#pragma unroll
                    for (int bj = 0; bj < 2; ++bj) st16_bf16(dst + bj * 128, acc[ai][bj][m][0] * w, acc[ai][bj][m][1] * w);
                }
                if (m & 1) asm volatile("" ::: "memory");
            }
        return false;
    }
};

__device__ __forceinline__ int map_win(int n) { if (n < 1024) return (n >> 7) * 256 + (n & 127); if (n < 2048) { const int q = n - 1024; return (q >> 7) * 256 + 128 + (q & 127); } return n; }
__device__ __forceinline__ int map_gu(int n) { const int q = n & 255, up = n >> 8; return (q >> 7) * 256 + up * 128 + (q & 127); }
template <int MODE>
__device__ __forceinline__ void p0_transpose_item(const float* W, int K, int N, bf16_t* WT, LAS float* scr, int item, int lane) {
    const int nblk = N / 32, kb = item / nblk, nb = item % nblk, k0 = 64 * kb, n0 = 32 * nb;
#pragma unroll 8
    for (int i = 0; i < 32; ++i) { const int kk = 2 * i + (lane >> 5); scr[kk * 33 + (lane & 31)] = W[(size_t)(k0 + kk) * N + n0 + (lane & 31)]; }
    asm volatile("s_waitcnt lgkmcnt(0)" ::: "memory");
    const int c = lane & 7;
#pragma unroll
    for (int j = 0; j < 4; ++j) { const int n = (lane >> 3) + 8 * j; const LAS float* s = scr + (8 * c) * 33 + n;
        u32x4 o; o.x = cvtpk(s[0 * 33], s[1 * 33]); o.y = cvtpk(s[2 * 33], s[3 * 33]); o.z = cvtpk(s[4 * 33], s[5 * 33]); o.w = cvtpk(s[6 * 33], s[7 * 33]);
        const int nn = n0 + n; const int row = MODE == 1 ? map_win(nn) : (MODE == 2 ? map_gu(nn) : nn);
        *(u32x4*)(WT + (size_t)row * K + k0 + 8 * c) = o; }
    asm volatile("s_waitcnt lgkmcnt(0)" ::: "memory");
}

struct Frame {
    LAS unsigned char* lds;
    int tid, lane, wave, G, bid;
    const float* const* in;
    float* out; unsigned char* ws;
};

__device__ __forceinline__ void phase0(const Frame& F, const Params& P) {
    unsigned char* ws = P.ws;
    LAS float* scr = (LAS float*)(F.lds + F.wave * 16384);
    const int gw = F.bid * 8 + F.wave, NGW = F.G * 8;
    for (int i = F.bid * NTHREADS + F.tid; i < NBATCH * 2 * HPAD * 128; i += F.G * NTHREADS) {
        const int rr = i >> 7, c8 = (i & 127) * 8, b = rr / (2 * HPAD), q = rr % (2 * HPAD);
        const int hrow = b * HROWS + (q < HPAD ? q : SEQ + q);
        *(u32x4*)((bf16_t*)(ws + WS_B) + (size_t)hrow * 1024 + c8) = (u32x4){0u, 0u, 0u, 0u};
    }
    if (F.bid == 0 && F.tid < NEXP) ((int*)(ws + WS_CTL))[CW_CNT + F.tid] = 0;
    constexpr int I_IN = 16 * (INW / 32), I_SQ = 16 * 32, I_GU = 16 * 16, I_DN = 4 * 32;
    constexpr int NITEMS = I_IN + 3 * I_SQ + NEXP * I_GU + NEXP * I_DN;
    for (int it = gw; it < NITEMS; it += NGW) {
        int r = it;
        if (r < I_IN) { p0_transpose_item<1>(P.in[1], D, INW, (bf16_t*)(ws + WS_WIN), scr, r, F.lane); continue; } r -= I_IN;
        if (r < I_SQ) { p0_transpose_item<0>(P.in[7], D, D, (bf16_t*)(ws + WS_WC), scr, r, F.lane); continue; } r -= I_SQ;
        if (r < I_SQ) { p0_transpose_item<0>(P.in[9], D, D, (bf16_t*)(ws + WS_WA), scr, r, F.lane); continue; } r -= I_SQ;
        if (r < I_SQ) { p0_transpose_item<0>(P.in[10], D, D, (bf16_t*)(ws + WS_WO), scr, r, F.lane); continue; } r -= I_SQ;
        if (r < NEXP * I_GU) { const int e = r / I_GU; p0_transpose_item<2>(P.in[17] + (size_t)e * D * 512, D, 512, (bf16_t*)(ws + WS_WGU) + (size_t)e * 512 * D, scr, r % I_GU, F.lane); continue; } r -= NEXP * I_GU;
        { const int e = r / I_DN; p0_transpose_item<0>(P.in[18] + (size_t)e * EH * D, EH, D, (bf16_t*)(ws + WS_WD) + (size_t)e * D * EH, scr, r % I_DN, F.lane); }
    }
    {
        bf16_t* wh = (bf16_t*)(ws + WS_WR); bf16_t* wl = wh + 48 * 1024;
        for (int idx = F.bid * NTHREADS + F.tid; idx < 48 * 1024; idx += F.G * NTHREADS) {
            const int col = idx >> 10, k = idx & 1023;
            float v = 0.f; if (col < 4) v = P.in[13][k * 4 + col]; else if (col < 36) v = P.in[15][k * 32 + (col - 4)];
            const unsigned h = cvtpk(v, 0.f) & 0xffffu; const float r = v - bf2f(h);
            wh[idx] = (bf16_t)h; wl[idx] = (bf16_t)(cvtpk(r, 0.f) & 0xffffu);
        }
    }
    {
        const float* x = P.in[0]; bf16_t* xb = (bf16_t*)(ws + WS_A);
        const size_t n8 = (size_t)M * D / 8;
        for (size_t i = (size_t)F.bid * NTHREADS + F.tid; i < n8; i += (size_t)F.G * NTHREADS) {
            const f32x4 a = *(const f32x4*)(x + i * 8), b = *(const f32x4*)(x + i * 8 + 4);
            st16_bf16(xb + i * 8, a, b);
        }
    }
}

template <int R, int T> struct ConvStep { static __device__ __forceinline__ void run(f32x2 (&acc)[32], const f32x2 (&w)[31], f32x2 xv) {
    constexpr int j = R - T; if constexpr (j >= 0 && j < 31) acc[T] += w[j] * xv; ConvStep<R, T + 1>::run(acc, w, xv); } };
template <int R> struct ConvStep<R, 32> { static __device__ __forceinline__ void run(f32x2 (&)[32], const f32x2 (&)[31], f32x2) {} };
template <int R> struct ConvRow { static __device__ __forceinline__ void run(f32x2 (&acc)[32], const f32x2 (&w)[31], const bf16_t* Hb) {
    const unsigned xw = *(const unsigned*)(Hb + (size_t)R * 1024); const f32x2 xv = {bflo(xw), bfhi(xw)};
    ConvStep<R, 0>::run(acc, w, xv); ConvRow<R + 1>::run(acc, w, Hb); } };
template <> struct ConvRow<62> { static __device__ __forceinline__ void run(f32x2 (&)[32], const f32x2 (&)[31], const bf16_t*) {} };
__device__ __forceinline__ void conv_tile(const Frame& F, const Params& P, int tile) {
    const bf16_t* H = (const bf16_t*)(P.ws + WS_B); bf16_t* hc = (bf16_t*)(P.ws + WS_A);
    const float* w_dw = P.in[3]; const float* b_dw = P.in[4]; const float* lg = P.in[5]; const float* lb = P.in[6];
    const int b = tile >> 8, t0 = (tile & 255) * 32, c2 = F.tid * 2;
    f32x2 acc[32];
    { const f32x2 bb = *(const f32x2*)(b_dw + c2);
#pragma unroll
      for (int t = 0; t < 32; ++t) acc[t] = bb; }
    f32x2 w[31];
#pragma unroll
    for (int j = 0; j < 31; ++j) w[j] = *(const f32x2*)(w_dw + j * 1024 + c2);
    const bf16_t* Hb = H + ((size_t)b * HROWS + t0) * 1024 + c2;
    ConvRow<0>::run(acc, w, Hb);
    LAS f32x2* red = (LAS f32x2*)F.lds;
#pragma unroll
    for (int t = 0; t < 32; ++t) red[t * 512 + F.tid] = (f32x2){acc[t].x + acc[t].y, acc[t].x * acc[t].x + acc[t].y * acc[t].y};
    __syncthreads();
    LAS f32x2* st = (LAS f32x2*)(F.lds + 131072);
#pragma unroll
    for (int q = 0; q < 4; ++q) { const int t = F.wave * 4 + q; f32x2 s = {0.f, 0.f};
#pragma unroll
        for (int i = 0; i < 8; ++i) { const f32x2 v = red[t * 512 + i * 64 + F.lane]; s += v; }
        const float s1 = wave_sum(s.x), s2 = wave_sum(s.y);
        const float mean = s1 * (1.f / 1024.f), var = s2 * (1.f / 1024.f) - mean * mean;
        if (F.lane == 0) st[t] = (f32x2){mean, 1.0f / sqrtf(fmaxf(var, 0.f) + LN_EPS)};
    }
    __syncthreads();
    const f32x2 gg = *(const f32x2*)(lg + c2), bb2 = *(const f32x2*)(lb + c2);
    bf16_t* ob = hc + ((size_t)b * SEQ + t0) * 1024 + c2;
#pragma unroll
    for (int t = 0; t < 32; ++t) { const f32x2 ms = st[t];
        const float v0 = (acc[t].x - ms.x) * ms.y * gg.x + bb2.x, v1 = (acc[t].y - ms.x) * ms.y * gg.y + bb2.y;
        *(unsigned*)(ob + (size_t)t * 1024) = cvtpk(v0 * sigmoidf_(v0), v1 * sigmoidf_(v1)); }
    __syncthreads();
}

#define KSWZ(row, colB) ((row) * 256 + ((colB) ^ (((row) & 7) << 4)))
#define SBAR() __builtin_amdgcn_sched_barrier(0)
__device__ __forceinline__ int crow(int r, int hi) { return (r & 3) + 8 * (r >> 2) + 4 * hi; }
__device__ __forceinline__ int v_st(int k, int c) { const int kk = (k & ~0xC) | ((k & 4) << 1) | ((k & 8) >> 1); return ((kk >> 3) * 4 + (c >> 5)) * 512 + ((kk & 7) * 32 + (c & 31)) * 2; }
__device__ __forceinline__ int v_rd_base(int lane) { return ((lane & 3) << 3) | (((lane >> 2) & 3) << 6) | (((lane >> 4) & 1) << 5) | (((lane >> 5) & 1) << 8); }
constexpr int v_rd_off(int d0, int ks, int half) { return d0 * 512 + ks * 4096 + half * 2048; }
template <int OFF> __device__ __forceinline__ s16x4 tr_read(int vb) {
    s16x4 r; asm volatile("ds_read_b64_tr_b16 %0, %1 offset:%2" : "=&v"(r) : "v"(vb), "i"(OFF) : "memory"); return r;
}
template <int D0> __device__ __forceinline__ void pv_one(f32x16& od, int vb, bf16x8 pa0, bf16x8 pa1, bf16x8 pa2, bf16x8 pa3) {
    const s16x4 l0 = tr_read<v_rd_off(D0, 0, 0)>(vb), h0 = tr_read<v_rd_off(D0, 0, 1)>(vb), l1 = tr_read<v_rd_off(D0, 1, 0)>(vb), h1 = tr_read<v_rd_off(D0, 1, 1)>(vb);
    const s16x4 l2 = tr_read<v_rd_off(D0, 2, 0)>(vb), h2 = tr_read<v_rd_off(D0, 2, 1)>(vb), l3 = tr_read<v_rd_off(D0, 3, 0)>(vb), h3 = tr_read<v_rd_off(D0, 3, 1)>(vb);
    asm volatile("s_waitcnt lgkmcnt(0)" ::: "memory"); SBAR();
#define PK(L, Hh) (bf16x8){L[0], L[1], L[2], L[3], Hh[0], Hh[1], Hh[2], Hh[3]}
    od = __builtin_amdgcn_mfma_f32_32x32x16_bf16(pa0, PK(l0, h0), od, 0, 0, 0);
    od = __builtin_amdgcn_mfma_f32_32x32x16_bf16(pa1, PK(l1, h1), od, 0, 0, 0);
    od = __builtin_amdgcn_mfma_f32_32x32x16_bf16(pa2, PK(l2, h2), od, 0, 0, 0);
    od = __builtin_amdgcn_mfma_f32_32x32x16_bf16(pa3, PK(l3, h3), od, 0, 0, 0);
#undef PK
}
constexpr int SHM_KV = 64 * 128 * 2;

__device__ __forceinline__ void attn_item(const Frame& F, const Params& P, int item) {
    bf16_t* Qb = (bf16_t*)(P.ws + WS_C); const bf16_t* Kb = (const bf16_t*)(P.ws + WS_D); const bf16_t* Vb = Kb + (size_t)M * 512;
    const int hkv = item & 3, n = (item >> 2) & 63, b = item >> 8;
    const int wid = F.wave, lane = F.lane, r32 = lane & 31, hi = lane >> 5;
    const int g = wid >> 2, qh = hkv * 2 + g, qrow0 = (wid & 3) * 32;
    const size_t tok0 = (size_t)b * SEQ;
    const int qmin = n * 128 + qrow0, qpos = qmin + r32;
    char* lds = (char*)F.lds;
    bf16_t* V_lds = (bf16_t*)lds; bf16_t* K_lds = (bf16_t*)(lds + SHM_KV);
    float* wsl = (float*)(lds + 2 * SHM_KV) + wid * 64; float* li_l = wsl; float* al_l = wsl + 32;
    bf16x8 qr[8];
    { const bf16_t* Qw = Qb + (tok0 + qpos) * 1024 + qh * 128 + hi * 8;
#pragma unroll
      for (int d0 = 0; d0 < 8; ++d0) qr[d0] = *(const bf16x8*)(Qw + d0 * 16); }
    constexpr float C = 0.08838834764831845f * LOG2E;
    const float slope2 = __builtin_amdgcn_exp2f(-(float)(qh + 1)) * LOG2E;
    float m_reg = P.in[8][qh] * LOG2E, l_reg = 1.0f;
    f32x16 o[4];
#pragma unroll
    for (int d = 0; d < 4; ++d)
#pragma unroll
        for (int r = 0; r < 16; ++r) o[d][r] = 0.f;
    const int jlo = (n == 0) ? 2 : 0, jhi = (n == 63) ? 4 : 6;
    const int kstart = n * 128 - 128;
    const int sr = F.tid >> 4, sc = (F.tid & 15) * 8, vst0 = v_st(sr, sc), vst1 = v_st(32 + sr, sc);
    const int vb0 = (int)(uintptr_t)V_lds + v_rd_base(lane);
    const bf16_t* Kg = Kb + tok0 * 512 + hkv * 128 + sc; const bf16_t* Vg = Vb + tok0 * 512 + hkv * 128 + sc;
    bf16x8 vs0, vs1, ks0, ks1;
#define SLOAD(k0) do { vs0 = *(const bf16x8*)(Vg + (size_t)((k0) + sr) * 512); vs1 = *(const bf16x8*)(Vg + (size_t)((k0) + 32 + sr) * 512); \
        ks0 = *(const bf16x8*)(Kg + (size_t)((k0) + sr) * 512); ks1 = *(const bf16x8*)(Kg + (size_t)((k0) + 32 + sr) * 512); } while (0)
    SLOAD(kstart + 64 * jlo);
    for (int j = jlo; j < jhi; ++j) {
        __syncthreads();
        *(bf16x8*)((char*)V_lds + vst0) = vs0; *(bf16x8*)((char*)V_lds + vst1) = vs1;
        *(bf16x8*)((char*)K_lds + KSWZ(sr, sc * 2)) = ks0; *(bf16x8*)((char*)K_lds + KSWZ(32 + sr, sc * 2)) = ks1;
        __syncthreads();
        if (j + 1 < jhi) SLOAD(kstart + 64 * (j + 1));
        const int kp0 = kstart + 64 * j;
        if (kp0 + 63 >= qmin - 128 && kp0 <= qmin + 31 + 128) {
            f32x16 p0, p1;
#pragma unroll
            for (int r = 0; r < 16; ++r) { p0[r] = 0.f; p1[r] = 0.f; }
#pragma unroll
            for (int d0 = 0; d0 < 8; ++d0) { const int cb = (d0 * 16 + hi * 8) * 2;
                const bf16x8 b0 = *(const bf16x8*)((const char*)K_lds + KSWZ(r32, cb));
                const bf16x8 b1 = *(const bf16x8*)((const char*)K_lds + KSWZ(32 + r32, cb));
                p0 = __builtin_amdgcn_mfma_f32_32x32x16_bf16(b0, qr[d0], p0, 0, 0, 0);
                p1 = __builtin_amdgcn_mfma_f32_32x32x16_bf16(b1, qr[d0], p1, 0, 0, 0); }
            const int rel0 = kp0 + 4 * hi - qpos;
            float pmax = -3.0e38f;
#pragma unroll
            for (int r = 0; r < 16; ++r) { const int cofs = (r & 3) + 8 * (r >> 2);
                const float d0f = fabsf((float)(rel0 + cofs)), d1f = fabsf((float)(rel0 + cofs + 32));
                float t0 = fmaf(p0[r], C, -slope2 * d0f), t1 = fmaf(p1[r], C, -slope2 * d1f);
                t0 = d0f > 128.f ? -1e30f : t0; t1 = d1f > 128.f ? -1e30f : t1;
                p0[r] = t0; p1[r] = t1; pmax = fmaxf(pmax, fmaxf(t0, t1)); }
            { auto rr = __builtin_amdgcn_permlane32_swap(__float_as_uint(pmax), __float_as_uint(pmax), false, false);
              pmax = fmaxf(__uint_as_float(rr[0]), __uint_as_float(rr[1])); }
            const float mn = fmaxf(m_reg, pmax), alpha = __builtin_amdgcn_exp2f(m_reg - mn); m_reg = mn;
            float ps = 0.f;
#pragma unroll
            for (int r = 0; r < 16; ++r) { p0[r] = __builtin_amdgcn_exp2f(p0[r] - mn); p1[r] = __builtin_amdgcn_exp2f(p1[r] - mn); ps += p0[r] + p1[r]; }
            { auto rr = __builtin_amdgcn_permlane32_swap(__float_as_uint(ps), __float_as_uint(ps), false, false);
              ps = __uint_as_float(rr[0]) + __uint_as_float(rr[1]); }
            l_reg = l_reg * alpha + ps;
            bf16x8 pa0, pa1, pa2, pa3;
#define PK4(Pp, BASE, OUT) do { unsigned a0 = cvtpk(Pp[BASE + 0], Pp[BASE + 1]), a1 = cvtpk(Pp[BASE + 2], Pp[BASE + 3]);   \
    unsigned b0 = cvtpk(Pp[BASE + 4], Pp[BASE + 5]), b1 = cvtpk(Pp[BASE + 6], Pp[BASE + 7]);                              \
    auto r0 = __builtin_amdgcn_permlane32_swap(a0, b0, false, false); auto r1 = __builtin_amdgcn_permlane32_swap(a1, b1, false, false); \
    u32x4 w = {r0[0], r1[0], r0[1], r1[1]}; OUT = __builtin_bit_cast(bf16x8, w); } while (0)
            PK4(p0, 0, pa0); PK4(p0, 8, pa1); PK4(p1, 0, pa2); PK4(p1, 8, pa3);
#undef PK4
            if (__any(alpha < 1.f)) { if (hi == 0) al_l[r32] = alpha; asm volatile("s_waitcnt lgkmcnt(0)" ::: "memory");
#pragma unroll
                for (int r = 0; r < 16; ++r) { const float a = al_l[crow(r, hi)];
#pragma unroll
                    for (int d = 0; d < 4; ++d) o[d][r] *= a; } }
            SBAR();
            pv_one<0>(o[0], vb0, pa0, pa1, pa2, pa3); pv_one<1>(o[1], vb0, pa0, pa1, pa2, pa3); pv_one<2>(o[2], vb0, pa0, pa1, pa2, pa3); pv_one<3>(o[3], vb0, pa0, pa1, pa2, pa3);
        }
    }
#undef SLOAD
    if (hi == 0) li_l[r32] = l_reg; asm volatile("s_waitcnt lgkmcnt(0)" ::: "memory");
    bf16_t* Ow = Qb + (tok0 + qmin) * 1024 + qh * 128 + r32;
#pragma unroll
    for (int r = 0; r < 16; ++r) { const int orow = crow(r, hi); const float rl = __builtin_amdgcn_rcpf(li_l[orow]);
#pragma unroll
        for (int d0 = 0; d0 < 4; ++d0) Ow[(size_t)orow * 1024 + d0 * 32] = (bf16_t)(cvtpk(o[d0][r] * rl, 0.f) & 0xffffu); }
}

constexpr int P5_STRIDE = 2064;
__device__ __forceinline__ void p5_tile(const Frame& F, const Params& P, int tile) {
    const float* y = (const float*)(P.ws + WS_E); bf16_t* x1b = (bf16_t*)(P.ws + WS_A);
    float* stat = (float*)(P.ws + WS_STAT); float* tokw = (float*)(P.ws + WS_TOKW); int* list = (int*)(P.ws + WS_LIST); int* cnt = (int*)(P.ws + WS_CTL) + CW_CNT;
    const bf16_t* wrh = (const bf16_t*)(P.ws + WS_WR); const bf16_t* wrl = wrh + 48 * 1024;
    LAS unsigned char* hi_l = F.lds; LAS unsigned char* lo_l = F.lds + 32 * P5_STRIDE; LAS float* logit = (LAS float*)(F.lds + 64 * P5_STRIDE);
    const int lane = F.lane, w = F.wave, tok0 = tile * 32;
    f32x4 gj[4], bj[4];
#pragma unroll
    for (int j = 0; j < 4; ++j) { gj[j] = *(const f32x4*)(P.in[11] + 4 * lane + 256 * j); bj[j] = *(const f32x4*)(P.in[12] + 4 * lane + 256 * j); }
#pragma unroll 1
    for (int tt = 0; tt < 4; ++tt) {
        const int row = 4 * w + tt; const size_t tok = (size_t)tok0 + row;
        f32x4 v[4]; float s = 0.f;
#pragma unroll
        for (int j = 0; j < 4; ++j) { v[j] = *(const f32x4*)(y + tok * 1024 + 4 * lane + 256 * j); s += (v[j].x + v[j].y) + (v[j].z + v[j].w); }
        const float mean = wave_sum(s) * (1.f / 1024.f); float s2 = 0.f;
#pragma unroll
        for (int j = 0; j < 4; ++j) { v[j] = v[j] - mean; s2 += (v[j].x * v[j].x + v[j].y * v[j].y) + (v[j].z * v[j].z + v[j].w * v[j].w); }
        const float rstd = 1.0f / sqrtf(wave_sum(s2) * (1.f / 1024.f) + LN_EPS);
        if (lane == 0) { stat[tok * 2] = mean; stat[tok * 2 + 1] = rstd; }
#pragma unroll
        for (int j = 0; j < 4; ++j) {
            const f32x4 xv = v[j] * rstd * gj[j] + bj[j];
            const unsigned h0 = cvtpk(xv.x, xv.y), h1 = cvtpk(xv.z, xv.w);
            *(u32x2*)(x1b + tok * 1024 + 4 * lane + 256 * j) = (u32x2){h0, h1};
            const unsigned l0 = cvtpk(xv.x - bflo(h0), xv.y - bfhi(h0)), l1 = cvtpk(xv.z - bflo(h1), xv.w - bfhi(h1));
            *(LAS u32x2*)(hi_l + row * P5_STRIDE + (4 * lane + 256 * j) * 2) = (u32x2){h0, h1};
            *(LAS u32x2*)(lo_l + row * P5_STRIDE + (4 * lane + 256 * j) * 2) = (u32x2){l0, l1};
        }
    }
    __syncthreads();
    if (w < 6) {
        const int mb = w / 3, nb = w % 3;
        f32x4 acc = {0.f, 0.f, 0.f, 0.f};
        const LAS unsigned char* ah = hi_l + (mb * 16 + (lane & 15)) * P5_STRIDE + (lane >> 4) * 16;
        const LAS unsigned char* al = lo_l + (mb * 16 + (lane & 15)) * P5_STRIDE + (lane >> 4) * 16;
        const bf16_t* bh = wrh + (nb * 16 + (lane & 15)) * 1024 + (lane >> 4) * 8; const bf16_t* bl = wrl + (nb * 16 + (lane & 15)) * 1024 + (lane >> 4) * 8;
#pragma unroll 4
        for (int ks = 0; ks < 32; ++ks) {
            const bf16x8 a_h = *(const LAS bf16x8*)(ah + ks * 64), a_l = *(const LAS bf16x8*)(al + ks * 64);
            const bf16x8 b_h = *(const bf16x8*)(bh + ks * 32), b_l = *(const bf16x8*)(bl + ks * 32);
            acc = __builtin_amdgcn_mfma_f32_16x16x32_bf16(a_h, b_h, acc, 0, 0, 0);
            acc = __builtin_amdgcn_mfma_f32_16x16x32_bf16(a_l, b_h, acc, 0, 0, 0);
            acc = __builtin_amdgcn_mfma_f32_16x16x32_bf16(a_h, b_l, acc, 0, 0, 0);
        }
#pragma unroll
        for (int r = 0; r < 4; ++r) logit[(mb * 16 + (lane >> 4) * 4 + r) * 48 + nb * 16 + (lane & 15)] = acc[r];
    }
    __syncthreads();
    if (F.tid < 32) {
        const int t = F.tid; const int tok = tok0 + t; const LAS float* lg = logit + t * 48;
        const float* brg = P.in[14]; const float* bre = P.in[16];
        float g0 = lg[0] + brg[0], g1 = lg[1] + brg[1], g2 = lg[2] + brg[2], g3 = lg[3] + brg[3];
        int gi = 0; float gm = g0; if (g1 > gm) { gm = g1; gi = 1; } if (g2 > gm) { gm = g2; gi = 2; } if (g3 > gm) { gm = g3; gi = 3; }
        const float gsum = __expf(g0 - gm) + __expf(g1 - gm) + __expf(g2 - gm) + __expf(g3 - gm);
        const float gw = 1.0f / gsum;
        float el[8];
#pragma unroll
        for (int i = 0; i < 8; ++i) el[i] = lg[4 + gi * 8 + i] + bre[gi * 8 + i];
        int i1 = 0; float m1 = el[0];
#pragma unroll
        for (int i = 1; i < 8; ++i) if (el[i] > m1) { m1 = el[i]; i1 = i; }
        int i2 = -1; float m2 = -3.0e38f;
#pragma unroll
        for (int i = 0; i < 8; ++i) if (i != i1 && el[i] > m2) { m2 = el[i]; i2 = i; }
        const float w1 = 1.0f / (1.0f + __expf(m2 - m1)), w2 = 1.0f - w1;
        const int e1 = gi * 8 + i1, e2 = gi * 8 + i2;
        tokw[tok * 2] = gw * w1; tokw[tok * 2 + 1] = gw * w2;
        const int p1 = atomicAdd(cnt + e1, 1); list[e1 * CAP + p1] = tok * 2;
        const int p2 = atomicAdd(cnt + e2, 1); list[e2 * CAP + p2] = tok * 2 + 1;
    }
    __syncthreads();
}

__device__ __forceinline__ void p8_row(const Frame& F, const Params& P, int tok) {
    const float* y = (const float*)(P.ws + WS_E); const float* stat = (const float*)(P.ws + WS_STAT);
    const bf16_t* S0 = (const bf16_t*)(P.ws + WS_C); const bf16_t* S1 = (const bf16_t*)(P.ws + WS_D);
    const int lane = F.lane; const size_t base = (size_t)tok * 1024 + 4 * lane;
    const float mean = stat[tok * 2], rstd = stat[tok * 2 + 1];
    f32x4 z[4]; float s = 0.f;
#pragma unroll
    for (int j = 0; j < 4; ++j) {
        const f32x4 yv = *(const f32x4*)(y + base + 256 * j);
        const f32x4 g1 = *(const f32x4*)(P.in[11] + 4 * lane + 256 * j), b1 = *(const f32x4*)(P.in[12] + 4 * lane + 256 * j);
        const u32x2 a = *(const u32x2*)(S0 + base + 256 * j), b = *(const u32x2*)(S1 + base + 256 * j);
        const f32x4 x1 = (yv - mean) * rstd * g1 + b1;
        const f32x4 mo = (f32x4){bflo(a.x) + bflo(b.x), bfhi(a.x) + bfhi(b.x), bflo(a.y) + bflo(b.y), bfhi(a.y) + bfhi(b.y)};
        z[j] = x1 * ALPHA + mo; s += (z[j].x + z[j].y) + (z[j].z + z[j].w);
    }
    const float m2 = wave_sum(s) * (1.f / 1024.f); float q = 0.f;
#pragma unroll
    for (int j = 0; j < 4; ++j) { z[j] = z[j] - m2; q += (z[j].x * z[j].x + z[j].y * z[j].y) + (z[j].z * z[j].z + z[j].w * z[j].w); }
    const float r2 = 1.0f / sqrtf(wave_sum(q) * (1.f / 1024.f) + LN_EPS);
#pragma unroll
    for (int j = 0; j < 4; ++j) {
        const f32x4 g2 = *(const f32x4*)(P.in[19] + 4 * lane + 256 * j), b2 = *(const f32x4*)(P.in[20] + 4 * lane + 256 * j);
        *(f32x4*)(P.out + base + 256 * j) = z[j] * r2 * g2 + b2;
    }
}

__device__ __forceinline__ void moe_prefix(const Frame& F, const Params& P) {
    LAS int* pre = (LAS int*)(F.lds + LDS_PRE);
    const int* cnt = (const int*)(P.ws + WS_CTL) + CW_CNT;
    if (F.tid == 0) { int acc = 0; pre[0] = 0;
        for (int e = 0; e < NEXP; ++e) { const int n = cnt[e]; pre[33 + e] = n; acc += (n + 255) >> 8; pre[e + 1] = acc; } }
    __syncthreads();
}

__global__ void __launch_bounds__(NTHREADS, 2) fwd_kernel(Params P) {
    extern __shared__ __attribute__((aligned(16))) unsigned char lds_raw[];
    cg::grid_group grid = cg::this_grid();
    Frame F;
    F.lds = (LAS unsigned char*)lds_raw; F.tid = threadIdx.x; F.lane = F.tid & 63; F.wave = __builtin_amdgcn_readfirstlane(F.tid >> 6);
    F.G = gridDim.x; F.bid = blockIdx.x; F.in = P.in; F.out = P.out; F.ws = P.ws;
    unsigned char* ws = P.ws;
    const int lo = P.ph_lo, hi = P.ph_hi;
#ifndef PHASE_MASK
#define PHASE_MASK 0x1ff
#endif
#define IN(k) (((PHASE_MASK >> (k)) & 1) && lo <= (k) && (k) < hi)
#define SEAM(k) do { if (IN(k) && IN((k) + 1)) grid.sync(); } while (0)

    if (IN(0)) { phase0(F, P); }
    SEAM(0);
    if (IN(1)) {
        ProbIn p; p.ws = ws; p.G = F.G; p.c = F.bid; p.b_gate = P.in[2];
        pg8::gemm_phase<ProbIn, true>(F.lds, p);
    }
    SEAM(1);
    if (IN(2)) {
#ifndef P2_SKIP_ATTN
        for (int it = F.bid; it < NBATCH * 64 * 4; it += F.G) attn_item(F, P, it);
#endif
        __syncthreads();
#ifndef P2_SKIP_CONV
        for (int t = F.bid; t < M / 32; t += F.G) conv_tile(F, P, t);
#endif
    }
    SEAM(2);
    if (IN(3)) {
        ProbMix p; p.ws = ws; p.G = F.G; p.c = F.bid;
        pg8::gemm_phase<ProbMix, true>(F.lds, p);
    }
    SEAM(3);
    if (IN(4)) {
        ProbOut p; p.A = (const bf16_t*)(ws + WS_B); p.Bt = (const bf16_t*)(ws + WS_WO); p.G = F.G; p.c = F.bid; p.x = P.in[0]; p.y = (float*)(ws + WS_E);
        pg8::gemm_phase<ProbOut, true>(F.lds, p);
    }
    SEAM(4);
    if (IN(5)) {
        for (int t = F.bid; t < M / 32; t += F.G) p5_tile(F, P, t);
    }
    SEAM(5);
    if (IN(6)) {
        moe_prefix(F, P);
        ProbMoe1 p; p.A = (const bf16_t*)(ws + WS_A); p.Bt = (const bf16_t*)(ws + WS_WGU); p.G = F.G; p.c = F.bid; p.pre = (const LAS int*)(F.lds + LDS_PRE);
        p.list = (const int*)(ws + WS_LIST); p.Hm = (bf16_t*)(ws + WS_B);
        pg8::gemm_phase<ProbMoe1, true>(F.lds, p);
    }
    SEAM(6);
    if (IN(7)) {
        moe_prefix(F, P);
        ProbMoe2 p; p.A = (const bf16_t*)(ws + WS_B); p.Bt = (const bf16_t*)(ws + WS_WD); p.G = F.G; p.c = F.bid; p.pre = (const LAS int*)(F.lds + LDS_PRE);
        p.list = (const int*)(ws + WS_LIST); p.tokw = (const float*)(ws + WS_TOKW); p.S0 = (bf16_t*)(ws + WS_C); p.S1 = (bf16_t*)(ws + WS_D);
        pg8::gemm_phase<ProbMoe2, true>(F.lds, p);
    }
    SEAM(7);
    if (IN(8)) {
        for (int tok = F.bid * 8 + F.wave; tok < M; tok += F.G * 8) p8_row(F, P, tok);
    }
#undef IN
#undef SEAM
}

#ifndef MK_ONE_LAUNCH
#define MK_ONE_LAUNCH 1
#endif
extern "C" void kernel_launch(void* const* d_in, const int* in_sizes, int n_in, void* d_out, int out_size, void* d_ws, size_t ws_size, hipStream_t stream) {
    static int grid = 0;
    if (grid == 0) {
        if (n_in != 21 || in_sizes[0] != M * D || out_size != M * D || ws_size < WS_END) {
            fprintf(stderr, "kernel_launch: unexpected shapes: n_in %d in0 %d out %d ws %zu (need >= %zu)\n", n_in, n_in > 0 ? in_sizes[0] : -1, out_size, ws_size, (size_t)WS_END);
            grid = -1; return; }
        int dev = 0, cus = 0, per_cu = 0;
        hipGetDevice(&dev); hipDeviceGetAttribute(&cus, hipDeviceAttributeMultiprocessorCount, dev);
        if (hipFuncSetAttribute((const void*)fwd_kernel, hipFuncAttributeMaxDynamicSharedMemorySize, LDS_BYTES) != hipSuccess) { fprintf(stderr, "kernel_launch: hipFuncSetAttribute failed\n"); grid = -1; return; }
        hipOccupancyMaxActiveBlocksPerMultiprocessor(&per_cu, (const void*)fwd_kernel, NTHREADS, LDS_BYTES);
        if (per_cu < 1) { fprintf(stderr, "kernel_launch: occupancy query says %d blocks per CU\n", per_cu); per_cu = 1; }
        (void)hipGetLastError();
        grid = cus;
    }
    if (grid < 0) return;
    Params p{};
    for (int i = 0; i < 21; ++i) p.in[i] = (const float*)d_in[i];
    p.out = (float*)d_out; p.ws = (unsigned char*)d_ws;
#if MK_ONE_LAUNCH
    p.ph_lo = 0; p.ph_hi = NPH;
    void* args[] = {&p};
    hipError_t e = hipLaunchCooperativeKernel((const void*)fwd_kernel, dim3(grid), dim3(NTHREADS), args, LDS_BYTES, stream);
    if (e != hipSuccess) fprintf(stderr, "kernel_launch: cooperative launch failed: %s (grid %d)\n", hipGetErrorString(e), grid);
#else
    for (int ph = 0; ph < NPH; ++ph) {
        p.ph_lo = ph; p.ph_hi = ph + 1;
        hipLaunchKernelGGL(fwd_kernel, dim3(grid), dim3(NTHREADS), LDS_BYTES, stream, p);
    }
    hipError_t e = hipPeekAtLastError();
    if (e != hipSuccess) fprintf(stderr, "kernel_launch: launch failed: %s\n", hipGetErrorString(e));
#endif
}
```

```cpp
#include <hip/hip_runtime.h>
#include <hip/hip_cooperative_groups.h>
#include <cstdio>
#include <cstdint>
namespace cg = cooperative_groups;

#define LAS __attribute__((address_space(3)))
typedef unsigned short bf16_t;
typedef short bf16x8 __attribute__((ext_vector_type(8)));
typedef short s16x4 __attribute__((ext_vector_type(4)));
typedef float f32x2 __attribute__((ext_vector_type(2)));
typedef float f32x4 __attribute__((ext_vector_type(4)));
typedef float f32x8 __attribute__((ext_vector_type(8)));
typedef float f32x16 __attribute__((ext_vector_type(16)));
typedef unsigned u32x2 __attribute__((ext_vector_type(2)));
typedef unsigned u32x4 __attribute__((ext_vector_type(4)));
typedef __bf16 bf16x2_t __attribute__((ext_vector_type(2)));
typedef int i32x2 __attribute__((ext_vector_type(2)));

constexpr int D = 1024, NBATCH = 4, SEQ = 8192, M = NBATCH * SEQ;
constexpr int INW = 6144;
constexpr int NEXP = 32, EH = 256;
constexpr int CAP = 32768;
constexpr float LN_EPS = 1e-5f;
constexpr float ALPHA = 1.189207115002721f;
constexpr float LOG2E = 1.4426950408889634f;
constexpr int NTHREADS = 512;
constexpr int NPH = 9;

constexpr size_t MiB = 1u << 20;
constexpr size_t WS_CTL = 0;
constexpr size_t WS_WIN = 2 * MiB;
constexpr size_t WS_WC = 14 * MiB, WS_WA = 16 * MiB, WS_WO = 18 * MiB;
constexpr size_t WS_WGU = 20 * MiB;
constexpr size_t WS_WD = 52 * MiB;
constexpr size_t WS_WR = 68 * MiB;
constexpr size_t WS_TOKW = 69 * MiB;
constexpr size_t WS_STAT = 70 * MiB;
constexpr size_t WS_LIST = 71 * MiB;
constexpr size_t WS_A = 80 * MiB;
constexpr size_t WS_B = 144 * MiB;
constexpr size_t WS_C = 209 * MiB;
constexpr size_t WS_D = 273 * MiB;
constexpr size_t WS_E = 337 * MiB;
constexpr size_t WS_END = 465 * MiB;
constexpr int HPAD = 15, HROWS = SEQ + 2 * HPAD;
constexpr int CW_CNT = 0;

constexpr int LDS_BYTES = 147456;
constexpr int LDS_PRE = 140288;

__device__ __forceinline__ unsigned cvtpk(float lo, float hi) { f32x2 v = {lo, hi}; bf16x2_t b = __builtin_convertvector(v, bf16x2_t); return __builtin_bit_cast(unsigned, b); }
__device__ __forceinline__ float bf2f(unsigned h) { return __uint_as_float(h << 16); }
__device__ __forceinline__ float bflo(unsigned w) { return __uint_as_float(w << 16); }
__device__ __forceinline__ float bfhi(unsigned w) { return __uint_as_float(w & 0xffff0000u); }
__device__ __forceinline__ float sigmoidf_(float x) { return __builtin_amdgcn_rcpf(1.0f + __builtin_amdgcn_exp2f(-x * LOG2E)); }
__device__ __forceinline__ float wave_sum(float v) {
#pragma unroll
    for (int o = 1; o < 64; o <<= 1) v += __shfl_xor(v, o);
    return v;
}

struct Params {
    const float* in[21];
    float* out;
    unsigned char* ws;
    int ph_lo, ph_hi;
};

namespace pg8 {
constexpr int BM = 256, BK = 64, HALF = 128, HTB = HALF * BK * 2, STAGE_BYTES = 8 * HTB, NXCD = 8, WGM = 8;
__host__ __device__ __forceinline__ int lds_byte(int r, int c) { const int st = (r >> 4) * 2 + (c >> 5), rr = r & 15, cc = c & 31, ob = rr * 64 + cc * 2; return st * 1024 + (ob ^ (((ob >> 9) & 1) << 5)); }
__host__ __device__ __forceinline__ void stage_rc(int b, int& R, int& C) { const int st = b / 1024, sb = b % 1024, swz = sb ^ (((sb >> 9) & 1) << 5); R = (st >> 1) * 16 + swz / 64; C = (st & 1) * 32 + (swz % 64) / 2; }
__host__ __device__ __forceinline__ int perm32(int rho) { const int n = rho >> 4, i = rho & 15; return 8 * (i >> 2) + 4 * n + (i & 3); }

struct Unit { int pm, pn, ex, lb, nv; };

__device__ __forceinline__ bool static_tile(int L, int nM, int nN, int& pm, int& pn) {
    const int nwg = nM * nN; if (L >= nwg) return false;
    int wgid = L; { const int q = nwg / NXCD, r = nwg % NXCD, xcd = wgid % NXCD, off = wgid / NXCD; wgid = (xcd < r ? xcd * (q + 1) : r * (q + 1) + (xcd - r) * q) + off; }
    const int nig = WGM * nN, gid = wgid / nig, fm = gid * WGM, gsz = (nM - fm) < WGM ? (nM - fm) : WGM;
    pm = fm + ((wgid % nig) % gsz); pn = (wgid % nig) / gsz; return true;
}

template <class P, bool ALIGN_EPI>
__device__ __forceinline__ void gemm_phase(LAS unsigned char* lds, const P& p) {
    constexpr int K = P::K; constexpr bool GATHER = P::GATHER;
    const int tid = threadIdx.x, wid = __builtin_amdgcn_readfirstlane(tid >> 6), lane = tid & 63, wr = wid >> 2, wc = wid & 3, fr = lane & 15, fq = lane >> 4;
    constexpr int nt = K / BK;
    unsigned voffB[2]; int Rr[2], Cc[2];
#pragma unroll
    for (int i = 0; i < 2; ++i) { int R, C; stage_rc(tid * 16 + i * 8192, R, C); const int Rb = (R & ~31) + perm32(R & 31); voffB[i] = (unsigned)(Rb * K + C) * 2u; Rr[i] = R; Cc[i] = C; }
    constexpr size_t kstep = (size_t)(BK * 2);
    constexpr size_t hstep = (size_t)HALF * K * 2;
    const unsigned ldsw = (unsigned)wid * 1024u;
    const int aoff = lds_byte(wr * 64 + fr, fq * 8), boff = lds_byte(wc * 32 + fr, fq * 8);
#define PG8_SA(b, h) (((b) * 2 + (h)) * HTB)
#define PG8_SB(b, h) ((4 + (b) * 2 + (h)) * HTB)
#define PG8_GL(src, dstoff) __builtin_amdgcn_global_load_lds((const unsigned*)(src), (LAS unsigned*)(lds + (dstoff)), 16, 0, 0)
#define PG8_STAGEB(bufoff, gbase) do { PG8_GL((const char*)(gbase) + voffB[0], (bufoff) + ldsw); PG8_GL((const char*)(gbase) + voffB[1], (bufoff) + ldsw + 8192); } while (0)
#define PG8_STAGEA(bufoff, gbase, v0, v1) do { PG8_GL((const char*)(gbase) + (v0), (bufoff) + ldsw); PG8_GL((const char*)(gbase) + (v1), (bufoff) + ldsw + 8192); } while (0)
#define PG8_LDA(dst, b, h) do { _Pragma("unroll") for (int m = 0; m < 4; ++m) _Pragma("unroll") for (int k = 0; k < 2; ++k) dst[m][k] = *(const LAS bf16x8*)(lds + PG8_SA(b, h) + aoff + m * 2048 + k * 1024); } while (0)
#define PG8_LDB(dst, b, h) do { _Pragma("unroll") for (int n = 0; n < 2; ++n) _Pragma("unroll") for (int k = 0; k < 2; ++k) dst[n][k] = *(const LAS bf16x8*)(lds + PG8_SB(b, h) + boff + n * 2048 + k * 1024); } while (0)
#define PG8_MMA(ai, bj, At, Bt) do { __builtin_amdgcn_s_setprio(1); _Pragma("unroll") for (int m = 0; m < 4; ++m) _Pragma("unroll") for (int n = 0; n < 2; ++n) _Pragma("unroll") for (int k = 0; k < 2; ++k) \
        acc[ai][bj][m][n] = __builtin_amdgcn_mfma_f32_16x16x32_bf16(Bt[n][k], At[m][k], acc[ai][bj][m][n], 0, 0, 0); __builtin_amdgcn_s_setprio(0); } while (0)
#define PG8_WAIT_V(n) asm volatile("s_waitcnt vmcnt(" #n ")" ::: "memory")
#define PG8_WAIT_L(n) asm volatile("s_waitcnt lgkmcnt(" #n ")" ::: "memory")
#define PG8_BAR __builtin_amdgcn_s_barrier()
#define PG8_SCHED __builtin_amdgcn_sched_barrier(0)
    Unit cur, nxt; int ui = 0;
    if (!p.next(0, cur)) return;
    f32x4 acc[2][2][4][2];
#pragma unroll
    for (int a = 0; a < 2; ++a)
#pragma unroll
        for (int b = 0; b < 2; ++b)
#pragma unroll
            for (int m = 0; m < 4; ++m)
#pragma unroll
                for (int n = 0; n < 2; ++n) acc[a][b][m][n] = (f32x4){0.f, 0.f, 0.f, 0.f};
    bf16x8 At[4][2], B0[2][2], B1[2][2];
    const char* cA = p.a_base(cur); const char* cB = p.b_base(cur);
    unsigned c00, c01, c10, c11;
    if constexpr (GATHER) { c00 = p.a_off(cur, Rr[0], Cc[0]); c01 = p.a_off(cur, Rr[1], Cc[1]); c10 = p.a_off(cur, Rr[0] + HALF, Cc[0]); c11 = p.a_off(cur, Rr[1] + HALF, Cc[1]); }
    else { c00 = (unsigned)(Rr[0] * K + Cc[0]) * 2u; c01 = (unsigned)(Rr[1] * K + Cc[1]) * 2u; c10 = c00 + (unsigned)hstep; c11 = c01 + (unsigned)hstep; }
    PG8_STAGEB(PG8_SB(0, 0), cB); PG8_STAGEB(PG8_SB(0, 1), cB + hstep); PG8_STAGEA(PG8_SA(0, 0), cA, c00, c01); PG8_STAGEA(PG8_SA(0, 1), cA, c10, c11);
    if (wr == 1) PG8_BAR;
    PG8_WAIT_V(2); PG8_BAR;
    PG8_STAGEB(PG8_SB(1, 0), cB + kstep); PG8_STAGEA(PG8_SA(1, 0), cA + kstep, c00, c01); PG8_STAGEB(PG8_SB(1, 1), cB + hstep + kstep);
    PG8_WAIT_V(6); PG8_BAR;
    for (;;) {
        const bool has_next = p.next(ui + 1, nxt);
        const char* nA = has_next ? p.a_base(nxt) : cA; const char* nB = has_next ? p.b_base(nxt) : cB;
        unsigned n00 = c00, n01 = c01, n10 = c10, n11 = c11;
        if constexpr (GATHER) { if (has_next) { n00 = p.a_off(nxt, Rr[0], Cc[0]); n01 = p.a_off(nxt, Rr[1], Cc[1]); n10 = p.a_off(nxt, Rr[0] + HALF, Cc[0]); n11 = p.a_off(nxt, Rr[1] + HALF, Cc[1]); } }
#pragma unroll 1
        for (int t = 0; t < nt; t += 2) {
            const bool last = (t == nt - 2);
            const char* a1 = cA + (size_t)(t + 1) * kstep;
            const char* a2 = last ? nA : cA + (size_t)(t + 2) * kstep; const char* b2 = last ? nB : cB + (size_t)(t + 2) * kstep;
            const char* a3 = a2 + kstep; const char* b3 = b2 + kstep;
            unsigned x00 = c00, x01 = c01, x10 = c10, x11 = c11;
            if constexpr (GATHER) { if (last) { x00 = n00; x01 = n01; x10 = n10; x11 = n11; } }
            PG8_LDB(B0, 0, 0); PG8_LDB(B1, 0, 1); PG8_SCHED; PG8_LDA(At, 0, 0); PG8_STAGEA(PG8_SA(1, 1), a1, c10, c11);
            PG8_WAIT_V(8); PG8_WAIT_L(0); PG8_BAR; PG8_MMA(0, 0, At, B0); PG8_MMA(0, 1, At, B1); PG8_BAR; PG8_SCHED;
            PG8_LDA(At, 0, 1); PG8_STAGEB(PG8_SB(0, 0), b2); PG8_STAGEB(PG8_SB(0, 1), b2 + hstep); PG8_STAGEA(PG8_SA(0, 0), a2, x00, x01);
            PG8_WAIT_V(8); PG8_WAIT_L(0); PG8_BAR; PG8_MMA(1, 0, At, B0); PG8_MMA(1, 1, At, B1); PG8_BAR; PG8_SCHED;
            PG8_LDB(B0, 1, 0); PG8_LDB(B1, 1, 1); PG8_SCHED; PG8_LDA(At, 1, 0); PG8_STAGEA(PG8_SA(0, 1), a2, x10, x11);
            PG8_WAIT_V(8); PG8_WAIT_L(0); PG8_BAR; PG8_MMA(0, 0, At, B0); PG8_MMA(0, 1, At, B1); PG8_BAR; PG8_SCHED;
            PG8_LDA(At, 1, 1); PG8_STAGEB(PG8_SB(1, 0), b3); PG8_STAGEB(PG8_SB(1, 1), b3 + hstep); PG8_STAGEA(PG8_SA(1, 0), a3, x00, x01);
            PG8_WAIT_V(8); PG8_WAIT_L(0); PG8_BAR; PG8_MMA(1, 0, At, B0); PG8_MMA(1, 1, At, B1); PG8_BAR; PG8_SCHED;
        }
        if constexpr (ALIGN_EPI) { if (wr == 0) PG8_BAR; }
        const bool keep = p.epi(acc, cur, wr, wc, fr, fq);
        if (!has_next) break;
        if (!keep) {
#pragma unroll
            for (int a = 0; a < 2; ++a)
#pragma unroll
                for (int b = 0; b < 2; ++b)
#pragma unroll
                    for (int m = 0; m < 4; ++m)
#pragma unroll
                        for (int n = 0; n < 2; ++n) acc[a][b][m][n] = (f32x4){0.f, 0.f, 0.f, 0.f};
        }
        cur = nxt; cA = nA; cB = nB; c00 = n00; c01 = n01; c10 = n10; c11 = n11; ++ui;
        if constexpr (ALIGN_EPI) { if (wr == 1) PG8_BAR; }
    }
    PG8_WAIT_V(0);
    if constexpr (!ALIGN_EPI) { if (wr == 0) PG8_BAR; }
    PG8_BAR;
#undef PG8_SA
#undef PG8_SB
#undef PG8_GL
#undef PG8_STAGEA
#undef PG8_STAGEB
#undef PG8_LDA
#undef PG8_LDB
#undef PG8_MMA
#undef PG8_WAIT_V
#undef PG8_WAIT_L
#undef PG8_BAR
#undef PG8_SCHED
}
}
using pg8::Unit;

__device__ __forceinline__ void st16_bf16(bf16_t* p, f32x4 v0, f32x4 v1) {
    u32x4 w; w.x = cvtpk(v0[0], v0[1]); w.y = cvtpk(v0[2], v0[3]); w.z = cvtpk(v1[0], v1[1]); w.w = cvtpk(v1[2], v1[3]);
    *(u32x4*)p = w;
}
__device__ __forceinline__ void ld8_bf16(const bf16_t* p, f32x4& v0, f32x4& v1) {
    const u32x4 w = *(const u32x4*)p;
    v0 = (f32x4){bflo(w.x), bfhi(w.x), bflo(w.y), bfhi(w.y)}; v1 = (f32x4){bflo(w.z), bfhi(w.z), bflo(w.w), bfhi(w.w)};
}

struct ProbIn {
    static constexpr int K = 1024; static constexpr bool GATHER = false;
    unsigned char* ws; int G, c; const float* b_gate;
    __device__ __forceinline__ bool next(int i, Unit& u) const { u.ex = 0; u.lb = 0; u.nv = 256; return pg8::static_tile(i * G + c, M / 256, INW / 256, u.pm, u.pn); }
    __device__ __forceinline__ const char* a_base(const Unit& u) const { return (const char*)(ws + WS_A) + (size_t)u.pm * 256 * K * 2; }
    __device__ __forceinline__ const char* b_base(const Unit& u) const { return (const char*)(ws + WS_WIN) + (size_t)u.pn * 256 * K * 2; }
    __device__ __forceinline__ bool epi(f32x4 (&acc)[2][2][4][2], const Unit& u, int wr, int wc, int fr, int fq) const {
        const int row0 = u.pm * 256 + wr * 64 + fr, cw = wc * 32 + 8 * fq;
        if (u.pn < 8) {
#pragma unroll
            for (int ai = 0; ai < 2; ++ai)
#pragma unroll
                for (int m = 0; m < 4; ++m) {
                    f32x4 h0, h1;
#pragma unroll
                    for (int e = 0; e < 4; ++e) { h0[e] = acc[ai][0][m][0][e] * sigmoidf_(acc[ai][1][m][0][e]); h1[e] = acc[ai][0][m][1][e] * sigmoidf_(acc[ai][1][m][1][e]); }
                    st16_bf16((bf16_t*)(ws + WS_B) + (size_t)(row0 + ai * 128 + m * 16 + 2 * HPAD * (u.pm >> 5) + HPAD) * 1024 + u.pn * 128 + cw, h0, h1);
                }
        } else if (u.pn < 16) {
            size_t boff; int ld, colt;
            if (u.pn < 12) { boff = WS_C; ld = 1024; colt = (u.pn - 8) * 256; } else if (u.pn < 14) { boff = WS_D; ld = 512; colt = (u.pn - 12) * 256; } else { boff = WS_D + (size_t)M * 512 * 2; ld = 512; colt = (u.pn - 14) * 256; }
            bf16_t* base = (bf16_t*)(ws + boff);
#pragma unroll
            for (int ai = 0; ai < 2; ++ai)
#pragma unroll
                for (int m = 0; m < 4; ++m)
#pragma unroll
                    for (int bj = 0; bj < 2; ++bj) st16_bf16(base + (size_t)(row0 + ai * 128 + m * 16) * ld + colt + bj * 128 + cw, acc[ai][bj][m][0], acc[ai][bj][m][1]);
        } else {
            const int colt = (u.pn - 16) * 256;
            f32x4 bv[2][2];
#pragma unroll
            for (int bj = 0; bj < 2; ++bj)
#pragma unroll
                for (int n = 0; n < 2; ++n) bv[bj][n] = *(const f32x4*)(b_gate + colt + bj * 128 + cw + 4 * n);
#pragma unroll
            for (int ai = 0; ai < 2; ++ai)
#pragma unroll
                for (int m = 0; m < 4; ++m)
#pragma unroll
                    for (int bj = 0; bj < 2; ++bj) {
                        f32x4 v0 = acc[ai][bj][m][0] + bv[bj][0], v1 = acc[ai][bj][m][1] + bv[bj][1];
#pragma unroll
                        for (int e = 0; e < 4; ++e) { v0[e] = sigmoidf_(v0[e]); v1[e] = sigmoidf_(v1[e]); }
                        st16_bf16((bf16_t*)(ws + WS_E) + (size_t)(row0 + ai * 128 + m * 16) * 2048 + colt + bj * 128 + cw, v0, v1);
                    }
        }
        return false;
    }
};

struct ProbMix {
    static constexpr int K = 1024; static constexpr bool GATHER = false;
    unsigned char* ws; int G, c;
    __device__ __forceinline__ bool next(int i, Unit& u) const { u.ex = i & 1; u.lb = 0; u.nv = 256; return pg8::static_tile((i >> 1) * G + c, M / 256, D / 256, u.pm, u.pn); }
    __device__ __forceinline__ const char* a_base(const Unit& u) const { return (const char*)(ws + (u.ex ? WS_C : WS_A)) + (size_t)u.pm * 256 * K * 2; }
    __device__ __forceinline__ const char* b_base(const Unit& u) const { return (const char*)(ws + (u.ex ? WS_WA : WS_WC)) + (size_t)u.pn * 256 * K * 2; }
    __device__ __forceinline__ bool epi(f32x4 (&acc)[2][2][4][2], const Unit& u, int wr, int wc, int fr, int fq) const {
        const int row0 = u.pm * 256 + wr * 64 + fr, col0 = u.pn * 256 + wc * 32 + 8 * fq;
        const bf16_t* Gt = (const bf16_t*)(ws + WS_E); bf16_t* Mx = (bf16_t*)(ws + WS_B);
        if (u.ex == 0) {
#pragma unroll
            for (int ai = 0; ai < 2; ++ai)
#pragma unroll
                for (int m = 0; m < 4; ++m)
#pragma unroll
                    for (int bj = 0; bj < 2; ++bj) {
                        const bf16_t* gp = Gt + (size_t)(row0 + ai * 128 + m * 16) * 2048 + col0 + bj * 128;
                        f32x4 c0, c1, a0, a1; ld8_bf16(gp, c0, c1); ld8_bf16(gp + 1024, a0, a1);
#pragma unroll
                        for (int e = 0; e < 4; ++e) { acc[ai][bj][m][0][e] *= c0[e] * __builtin_amdgcn_rcpf(a0[e]); acc[ai][bj][m][1][e] *= c1[e] * __builtin_amdgcn_rcpf(a1[e]); }
                    }
            return true;
        }
#pragma unroll
        for (int ai = 0; ai < 2; ++ai)
#pragma unroll
            for (int m = 0; m < 4; ++m)
#pragma unroll
                for (int bj = 0; bj < 2; ++bj) {
                    const size_t off = (size_t)(row0 + ai * 128 + m * 16);
                    f32x4 a0, a1; ld8_bf16(Gt + off * 2048 + 1024 + col0 + bj * 128, a0, a1);
                    st16_bf16(Mx + off * 1024 + col0 + bj * 128, acc[ai][bj][m][0] * a0, acc[ai][bj][m][1] * a1);
                }
        return false;
    }
};

struct ProbOut {
    static constexpr int K = 1024; static constexpr bool GATHER = false;
    const bf16_t *A, *Bt; int G, c;
    const float* x; float* y;
    __device__ __forceinline__ bool next(int i, Unit& u) const { u.ex = 0; u.lb = 0; u.nv = 256; return pg8::static_tile(i * G + c, M / 256, D / 256, u.pm, u.pn); }
    __device__ __forceinline__ const char* a_base(const Unit& u) const { return (const char*)(A + (size_t)u.pm * 256 * K); }
    __device__ __forceinline__ const char* b_base(const Unit& u) const { return (const char*)(Bt + (size_t)u.pn * 256 * K); }
    __device__ __forceinline__ bool epi(f32x4 (&acc)[2][2][4][2], const Unit& u, int wr, int wc, int fr, int fq) const {
        const int row0 = u.pm * 256 + wr * 64 + fr, col0 = u.pn * 256 + wc * 32 + 8 * fq;
#pragma unroll
        for (int ai = 0; ai < 2; ++ai)
#pragma unroll
            for (int m = 0; m < 4; ++m)
#pragma unroll
                for (int bj = 0; bj < 2; ++bj) {
                    const size_t off = (size_t)(row0 + ai * 128 + m * 16) * 1024 + col0 + bj * 128;
                    const f32x4 x0 = *(const f32x4*)(x + off), x1 = *(const f32x4*)(x + off + 4);
                    *(f32x4*)(y + off) = x0 * ALPHA + acc[ai][bj][m][0]; *(f32x4*)(y + off + 4) = x1 * ALPHA + acc[ai][bj][m][1];
                }
        return false;
    }
};

template <int NCOL>
__device__ __forceinline__ bool moe_next(const LAS int* pre, int L, Unit& u) {
    const int total = pre[NEXP] * NCOL; if (L >= total) return false;
    const int rtg = L / NCOL; u.pn = L - rtg * NCOL; int e = 0;
#pragma unroll 1
    for (int j = 1; j < NEXP; ++j) e += (pre[j] <= rtg) ? 1 : 0;
    e = __builtin_amdgcn_readfirstlane(e);
    const int rtl = rtg - pre[e], ne = pre[33 + e];
    u.pm = __builtin_amdgcn_readfirstlane(rtg); u.ex = e; u.lb = __builtin_amdgcn_readfirstlane(e * CAP + rtl * 256); u.nv = __builtin_amdgcn_readfirstlane(min(256, ne - rtl * 256));
    u.pn = __builtin_amdgcn_readfirstlane(u.pn);
    return true;
}
struct ProbMoe1 {
    static constexpr int K = 1024; static constexpr bool GATHER = true;
    const bf16_t *A, *Bt; int G, c; const LAS int* pre; const i32x2* list; bf16_t* Hm;
    __device__ __forceinline__ bool next(int i, Unit& u) const { return moe_next<2>(pre, i * G + c, u); }
    __device__ __forceinline__ const char* a_base(const Unit&) const { return (const char*)A; }
    __device__ __forceinline__ unsigned a_off(const Unit& u, int r, int cc) const { const int rr = r < u.nv ? r : u.nv - 1; const int ent = list[u.lb + rr].x; return (unsigned)((ent >> 1) * K + cc) * 2u; }
    __device__ __forceinline__ const char* b_base(const Unit& u) const { return (const char*)(Bt + ((size_t)u.ex * 512 + (size_t)u.pn * 256) * K); }
    __device__ __forceinline__ bool epi(f32x4 (&acc)[2][2][4][2], const Unit& u, int wr, int wc, int fr, int fq) const {
        const int row0 = u.pm * 256 + wr * 64 + fr, cw = u.pn * 128 + wc * 32 + 8 * fq;
#pragma unroll
        for (int ai = 0; ai < 2; ++ai)
#pragma unroll
            for (int m = 0; m < 4; ++m) {
                f32x4 h0, h1;
#pragma unroll
                for (int e = 0; e < 4; ++e) { const float g0 = acc[ai][0][m][0][e], g1 = acc[ai][0][m][1][e]; h0[e] = g0 * sigmoidf_(g0) * acc[ai][1][m][0][e]; h1[e] = g1 * sigmoidf_(g1) * acc[ai][1][m][1][e]; }
                st16_bf16(Hm + (size_t)(row0 + ai * 128 + m * 16) * EH + cw, h0, h1);
            }
        return false;
    }
};
struct ProbMoe2 {
    static constexpr int K = 256; static constexpr bool GATHER = false;
    const bf16_t *A, *Bt; int G, c; const LAS int* pre; const i32x2* list; bf16_t *S0, *S1;
    __device__ __forceinline__ bool next(int i, Unit& u) const { return moe_next<4>(pre, i * G + c, u); }
    __device__ __forceinline__ const char* a_base(const Unit& u) const { return (const char*)(A + (size_t)u.pm * 256 * K); }
    __device__ __forceinline__ const char* b_base(const Unit& u) const { return (const char*)(Bt + ((size_t)u.ex * 1024 + (size_t)u.pn * 256) * K); }
    __device__ __forceinline__ bool epi(f32x4 (&acc)[2][2][4][2], const Unit& u, int wr, int wc, int fr, int fq) const {
        const int col0 = u.pn * 256 + wc * 32 + 8 * fq;
        i32x2 ents[2][4];
#pragma unroll
        for (int ai = 0; ai < 2; ++ai)
#pragma unroll
            for (int m = 0; m < 4; ++m) { const int rl = ai * 128 + wr * 64 + m * 16 + fr; ents[ai][m] = (i32x2){-1, 0}; if (rl < u.nv) ents[ai][m] = list[u.lb + rl]; }
#pragma unroll
        for (int ai = 0; ai < 2; ++ai)
#pragma unroll
            for (int m = 0; m < 4; ++m) {
                const int ent = ents[ai][m].x;
                if (ent >= 0) {
                    const float w = __uint_as_float((unsigned)ents[ai][m].y);
                    bf16_t* dst = ((ent & 1) ? S1 : S0) + (size_t)(ent >> 1) * 1024 + col0;
#pragma unroll
                    for (int bj = 0; bj < 2; ++bj) st16_bf16(dst + bj * 128, acc[ai][bj][m][0] * w, acc[ai][bj][m][1] * w);
                }
            }
        return false;
    }
};

__device__ __forceinline__ int map_win(int n) { if (n < 1024) return (n >> 7) * 256 + (n & 127); if (n < 2048) { const int q = n - 1024; return (q >> 7) * 256 + 128 + (q & 127); } return n; }
__device__ __forceinline__ int map_gu(int n) { const int q = n & 255, up = n >> 8; return (q >> 7) * 256 + up * 128 + (q & 127); }
template <int MODE>
__device__ __forceinline__ void p0_transpose_item(const float* W, int K, int N, bf16_t* WT, LAS float* scr, int item, int lane) {
    const int nblk = N / 32, kb = item / nblk, nb = item % nblk, k0 = 64 * kb, n0 = 32 * nb;
#pragma unroll 8
    for (int i = 0; i < 32; ++i) { const int kk = 2 * i + (lane >> 5); scr[kk * 33 + (lane & 31)] = W[(size_t)(k0 + kk) * N + n0 + (lane & 31)]; }
    asm volatile("s_waitcnt lgkmcnt(0)" ::: "memory");
    const int c = lane & 7;
#pragma unroll
    for (int j = 0; j < 4; ++j) { const int n = (lane >> 3) + 8 * j; const LAS float* s = scr + (8 * c) * 33 + n;
        u32x4 o; o.x = cvtpk(s[0 * 33], s[1 * 33]); o.y = cvtpk(s[2 * 33], s[3 * 33]); o.z = cvtpk(s[4 * 33], s[5 * 33]); o.w = cvtpk(s[6 * 33], s[7 * 33]);
        const int nn = n0 + n; const int row = MODE == 1 ? map_win(nn) : (MODE == 2 ? map_gu(nn) : nn);
        *(u32x4*)(WT + (size_t)row * K + k0 + 8 * c) = o; }
    asm volatile("s_waitcnt lgkmcnt(0)" ::: "memory");
}

struct Frame {
    LAS unsigned char* lds;
    int tid, lane, wave, G, bid;
    const float* const* in;
    float* out; unsigned char* ws;
};

__device__ __forceinline__ void phase0(const Frame& F, const Params& P) {
    unsigned char* ws = P.ws;
    LAS float* scr = (LAS float*)(F.lds + F.wave * 16384);
    const int gw = F.bid * 8 + F.wave, NGW = F.G * 8;
    for (int i = F.bid * NTHREADS + F.tid; i < NBATCH * 2 * HPAD * 128; i += F.G * NTHREADS) {
        const int rr = i >> 7, c8 = (i & 127) * 8, b = rr / (2 * HPAD), q = rr % (2 * HPAD);
        const int hrow = b * HROWS + (q < HPAD ? q : SEQ + q);
        *(u32x4*)((bf16_t*)(ws + WS_B) + (size_t)hrow * 1024 + c8) = (u32x4){0u, 0u, 0u, 0u};
    }
    if (F.bid == 0 && F.tid < NEXP) ((int*)(ws + WS_CTL))[CW_CNT + F.tid] = 0;
    constexpr int I_IN = 16 * (INW / 32), I_SQ = 16 * 32, I_GU = 16 * 16, I_DN = 4 * 32;
    constexpr int NITEMS = I_IN + 3 * I_SQ + NEXP * I_GU + NEXP * I_DN;
    for (int it = gw; it < NITEMS; it += NGW) {
        int r = it;
        if (r < I_IN) { p0_transpose_item<1>(P.in[1], D, INW, (bf16_t*)(ws + WS_WIN), scr, r, F.lane); continue; } r -= I_IN;
        if (r < I_SQ) { p0_transpose_item<0>(P.in[7], D, D, (bf16_t*)(ws + WS_WC), scr, r, F.lane); continue; } r -= I_SQ;
        if (r < I_SQ) { p0_transpose_item<0>(P.in[9], D, D, (bf16_t*)(ws + WS_WA), scr, r, F.lane); continue; } r -= I_SQ;
        if (r < I_SQ) { p0_transpose_item<0>(P.in[10], D, D, (bf16_t*)(ws + WS_WO), scr, r, F.lane); continue; } r -= I_SQ;
        if (r < NEXP * I_GU) { const int e = r / I_GU; p0_transpose_item<2>(P.in[17] + (size_t)e * D * 512, D, 512, (bf16_t*)(ws + WS_WGU) + (size_t)e * 512 * D, scr, r % I_GU, F.lane); continue; } r -= NEXP * I_GU;
        { const int e = r / I_DN; p0_transpose_item<0>(P.in[18] + (size_t)e * EH * D, EH, D, (bf16_t*)(ws + WS_WD) + (size_t)e * D * EH, scr, r % I_DN, F.lane); }
    }
    {
        bf16_t* wh = (bf16_t*)(ws + WS_WR); bf16_t* wl = wh + 48 * 1024;
        for (int idx = F.bid * NTHREADS + F.tid; idx < 48 * 1024; idx += F.G * NTHREADS) {
            const int col = idx >> 10, k = idx & 1023;
            float v = 0.f; if (col < 4) v = P.in[13][k * 4 + col]; else if (col < 36) v = P.in[15][k * 32 + (col - 4)];
            const unsigned h = cvtpk(v, 0.f) & 0xffffu; const float r = v - bf2f(h);
            wh[idx] = (bf16_t)h; wl[idx] = (bf16_t)(cvtpk(r, 0.f) & 0xffffu);
        }
    }
    {
        const float* x = P.in[0]; bf16_t* xb = (bf16_t*)(ws + WS_A);
        const size_t n8 = (size_t)M * D / 8;
        for (size_t i = (size_t)F.bid * NTHREADS + F.tid; i < n8; i += (size_t)F.G * NTHREADS) {
            const f32x4 a = *(const f32x4*)(x + i * 8), b = *(const f32x4*)(x + i * 8 + 4);
            st16_bf16(xb + i * 8, a, b);
        }
    }
}

template <int R, int T> struct ConvStep { static __device__ __forceinline__ void run(f32x2 (&acc)[32], const f32x2 (&w)[31], f32x2 xv) {
    constexpr int j = R - T; if constexpr (j >= 0 && j < 31) acc[T] += w[j] * xv; ConvStep<R, T + 1>::run(acc, w, xv); } };
template <int R> struct ConvStep<R, 32> { static __device__ __forceinline__ void run(f32x2 (&)[32], const f32x2 (&)[31], f32x2) {} };
template <int R> struct ConvRow { static __device__ __forceinline__ void run(f32x2 (&acc)[32], const f32x2 (&w)[31], const bf16_t* Hb) {
    const unsigned xw = *(const unsigned*)(Hb + (size_t)R * 1024); const f32x2 xv = {bflo(xw), bfhi(xw)};
    ConvStep<R, 0>::run(acc, w, xv); ConvRow<R + 1>::run(acc, w, Hb); } };
template <> struct ConvRow<62> { static __device__ __forceinline__ void run(f32x2 (&)[32], const f32x2 (&)[31], const bf16_t*) {} };
__device__ __forceinline__ void conv_tile(const Frame& F, const Params& P, int tile) {
    const bf16_t* H = (const bf16_t*)(P.ws + WS_B); bf16_t* hc = (bf16_t*)(P.ws + WS_A);
    const float* w_dw = P.in[3]; const float* b_dw = P.in[4]; const float* lg = P.in[5]; const float* lb = P.in[6];
    const int b = tile >> 8, t0 = (tile & 255) * 32, c2 = F.tid * 2;
    f32x2 acc[32];
    { const f32x2 bb = *(const f32x2*)(b_dw + c2);
#pragma unroll
      for (int t = 0; t < 32; ++t) acc[t] = bb; }
    f32x2 w[31];
#pragma unroll
    for (int j = 0; j < 31; ++j) w[j] = *(const f32x2*)(w_dw + j * 1024 + c2);
    const bf16_t* Hb = H + ((size_t)b * HROWS + t0) * 1024 + c2;
    ConvRow<0>::run(acc, w, Hb);
    LAS f32x2* red = (LAS f32x2*)F.lds;
#pragma unroll
    for (int t = 0; t < 32; ++t) red[t * 512 + F.tid] = (f32x2){acc[t].x + acc[t].y, acc[t].x * acc[t].x + acc[t].y * acc[t].y};
    __syncthreads();
    LAS f32x2* st = (LAS f32x2*)(F.lds + 131072);
#pragma unroll
    for (int q = 0; q < 4; ++q) { const int t = F.wave * 4 + q; f32x2 s = {0.f, 0.f};
#pragma unroll
        for (int i = 0; i < 8; ++i) { const f32x2 v = red[t * 512 + i * 64 + F.lane]; s += v; }
        const float s1 = wave_sum(s.x), s2 = wave_sum(s.y);
        const float mean = s1 * (1.f / 1024.f), var = s2 * (1.f / 1024.f) - mean * mean;
        if (F.lane == 0) st[t] = (f32x2){mean, 1.0f / sqrtf(fmaxf(var, 0.f) + LN_EPS)};
    }
    __syncthreads();
    const f32x2 gg = *(const f32x2*)(lg + c2), bb2 = *(const f32x2*)(lb + c2);
    bf16_t* ob = hc + ((size_t)b * SEQ + t0) * 1024 + c2;
#pragma unroll
    for (int t = 0; t < 32; ++t) { const f32x2 ms = st[t];
        const float v0 = (acc[t].x - ms.x) * ms.y * gg.x + bb2.x, v1 = (acc[t].y - ms.x) * ms.y * gg.y + bb2.y;
        *(unsigned*)(ob + (size_t)t * 1024) = cvtpk(v0 * sigmoidf_(v0), v1 * sigmoidf_(v1)); }
    __syncthreads();
}

#define KSWZ(row, colB) ((row) * 256 + ((colB) ^ (((row) & 7) << 4)))
#define SBAR() __builtin_amdgcn_sched_barrier(0)
constexpr int VPITCH = 320;
constexpr int ATT_KSZ = 64 * 256, ATT_VSZ = 64 * VPITCH, ATT_V0 = 2 * ATT_KSZ;
template <int OFF> __device__ __forceinline__ s16x4 tr_read(int vb) {
    s16x4 r; asm volatile("ds_read_b64_tr_b16 %0, %1 offset:%2" : "=&v"(r) : "v"(vb), "i"(OFF) : "memory"); return r;
}
template <int D0> __device__ __forceinline__ void pv_one(f32x16& od, int vb, bf16x8 pb0, bf16x8 pb1, bf16x8 pb2, bf16x8 pb3) {
#define VOFF(s, half) (D0 * 64 + (16 * (s) + 8 * (half)) * VPITCH)
    const s16x4 l0 = tr_read<VOFF(0, 0)>(vb), h0 = tr_read<VOFF(0, 1)>(vb), l1 = tr_read<VOFF(1, 0)>(vb), h1 = tr_read<VOFF(1, 1)>(vb);
    const s16x4 l2 = tr_read<VOFF(2, 0)>(vb), h2 = tr_read<VOFF(2, 1)>(vb), l3 = tr_read<VOFF(3, 0)>(vb), h3 = tr_read<VOFF(3, 1)>(vb);
#undef VOFF
    asm volatile("s_waitcnt lgkmcnt(0)" ::: "memory"); SBAR();
#define PK(L, Hh) (bf16x8){L[0], L[1], L[2], L[3], Hh[0], Hh[1], Hh[2], Hh[3]}
    od = __builtin_amdgcn_mfma_f32_32x32x16_bf16(PK(l0, h0), pb0, od, 0, 0, 0);
    od = __builtin_amdgcn_mfma_f32_32x32x16_bf16(PK(l1, h1), pb1, od, 0, 0, 0);
    od = __builtin_amdgcn_mfma_f32_32x32x16_bf16(PK(l2, h2), pb2, od, 0, 0, 0);
    od = __builtin_amdgcn_mfma_f32_32x32x16_bf16(PK(l3, h3), pb3, od, 0, 0, 0);
#undef PK
}

__device__ __forceinline__ void attn_item(const Frame& F, const Params& P, int item) {
    bf16_t* Qb = (bf16_t*)(P.ws + WS_C); const bf16_t* Kb = (const bf16_t*)(P.ws + WS_D); const bf16_t* Vb = Kb + (size_t)M * 512;
    const int hkv = item & 3, n = (item >> 2) & 63, b = item >> 8;
    const int wid = F.wave, lane = F.lane, r32 = lane & 31, hi = lane >> 5;
    const int g = wid >> 2, qh = hkv * 2 + g, qrow0 = (wid & 3) * 32;
    const size_t tok0 = (size_t)b * SEQ;
    const int qmin = n * 128 + qrow0, qpos = qmin + r32;
    char* lds = (char*)F.lds;
    bf16x8 qr[8];
    { const bf16_t* Qw = Qb + (tok0 + qpos) * 1024 + qh * 128 + hi * 8;
#pragma unroll
      for (int d0 = 0; d0 < 8; ++d0) qr[d0] = *(const bf16x8*)(Qw + d0 * 16); }
    constexpr float C = 0.08838834764831845f * LOG2E;
    const float slope2 = __builtin_amdgcn_exp2f(-(float)(qh + 1)) * LOG2E;
    const float nbias = -slope2 * (1.0f / C);
    float m_reg = P.in[8][qh] * LOG2E, l_reg = 1.0f;
    f32x16 o[4];
#pragma unroll
    for (int d = 0; d < 4; ++d)
#pragma unroll
        for (int r = 0; r < 16; ++r) o[d][r] = 0.f;
    const int jlo = (n == 0) ? 2 : 0, jhi = (n == 63) ? 4 : 6;
    const int kstart = n * 128 - 128;
    const int sr = F.tid >> 4, sc = (F.tid & 15) * 8;
    const int kst0 = KSWZ(sr, sc * 2), kst1 = KSWZ(32 + sr, sc * 2), vst0 = ATT_V0 + sr * VPITCH + sc * 2, vst1 = ATT_V0 + (32 + sr) * VPITCH + sc * 2;
    const int vb0 = (int)(uintptr_t)(lds + ATT_V0) + (4 * hi + ((lane & 15) >> 2)) * VPITCH + (16 * ((lane >> 4) & 1) + 4 * (lane & 3)) * 2;
    const bf16_t* Kg = Kb + tok0 * 512 + hkv * 128 + sc; const bf16_t* Vg = Vb + tok0 * 512 + hkv * 128 + sc;
    bf16x8 vs0, vs1, ks0, ks1;
#define SLOAD(k0) do { vs0 = *(const bf16x8*)(Vg + (size_t)((k0) + sr) * 512); vs1 = *(const bf16x8*)(Vg + (size_t)((k0) + 32 + sr) * 512); \
        ks0 = *(const bf16x8*)(Kg + (size_t)((k0) + sr) * 512); ks1 = *(const bf16x8*)(Kg + (size_t)((k0) + 32 + sr) * 512); } while (0)
#define SWRITE(bf) do { *(bf16x8*)(lds + (bf) * ATT_KSZ + kst0) = ks0; *(bf16x8*)(lds + (bf) * ATT_KSZ + kst1) = ks1; \
        *(bf16x8*)(lds + (bf) * ATT_VSZ + vst0) = vs0; *(bf16x8*)(lds + (bf) * ATT_VSZ + vst1) = vs1; } while (0)
    SLOAD(kstart + 64 * jlo);
    SWRITE(0);
    SLOAD(kstart + 64 * (jlo + 1));
    __syncthreads();
    for (int j = jlo; j < jhi; ++j) {
        const int bf = (j - jlo) & 1;
        const int kp0 = kstart + 64 * j;
        if (kp0 + 63 >= qmin - 128 && kp0 <= qmin + 31 + 128) {
            const char* Kl = lds + bf * ATT_KSZ;
            const int rel0 = kp0 + 4 * hi - qpos;
            f32x16 p0, p1;
            const bool full = (kp0 >= qmin + 31 - 128) && (kp0 + 63 <= qmin + 128);
            if (full) {
#pragma unroll
                for (int r = 0; r < 16; ++r) { const int cofs = (r & 3) + 8 * (r >> 2);
                    p0[r] = nbias * fabsf((float)(rel0 + cofs)); p1[r] = nbias * fabsf((float)(rel0 + cofs + 32)); }
            } else {
#pragma unroll
                for (int r = 0; r < 16; ++r) { const int cofs = (r & 3) + 8 * (r >> 2);
                    const float d0f = fabsf((float)(rel0 + cofs)), d1f = fabsf((float)(rel0 + cofs + 32));
                    p0[r] = d0f > 128.f ? -1e30f : nbias * d0f; p1[r] = d1f > 128.f ? -1e30f : nbias * d1f; }
            }
#pragma unroll
            for (int d0 = 0; d0 < 8; ++d0) { const int cb = (d0 * 16 + hi * 8) * 2;
                const bf16x8 b0 = *(const bf16x8*)(Kl + KSWZ(r32, cb));
                const bf16x8 b1 = *(const bf16x8*)(Kl + KSWZ(32 + r32, cb));
                p0 = __builtin_amdgcn_mfma_f32_32x32x16_bf16(b0, qr[d0], p0, 0, 0, 0);
                p1 = __builtin_amdgcn_mfma_f32_32x32x16_bf16(b1, qr[d0], p1, 0, 0, 0); }
            float pmax = fmaxf(p0[0], p1[0]);
#pragma unroll
            for (int r = 1; r < 16; ++r) pmax = fmaxf(pmax, fmaxf(p0[r], p1[r]));
            { auto rr = __builtin_amdgcn_permlane32_swap(__float_as_uint(pmax), __float_as_uint(pmax), false, false);
              pmax = fmaxf(__uint_as_float(rr[0]), __uint_as_float(rr[1])); }
            const float mn = fmaxf(m_reg, pmax * C), alpha = __builtin_amdgcn_exp2f(m_reg - mn); m_reg = mn;
            float ps = 0.f;
#pragma unroll
            for (int r = 0; r < 16; ++r) { p0[r] = __builtin_amdgcn_exp2f(fmaf(p0[r], C, -mn)); p1[r] = __builtin_amdgcn_exp2f(fmaf(p1[r], C, -mn)); ps += p0[r] + p1[r]; }
            { auto rr = __builtin_amdgcn_permlane32_swap(__float_as_uint(ps), __float_as_uint(ps), false, false);
              ps = __uint_as_float(rr[0]) + __uint_as_float(rr[1]); }
            l_reg = l_reg * alpha + ps;
            bf16x8 pb0, pb1, pb2, pb3;
#define PB(Pp, BASE, OUT) do { u32x4 w = {cvtpk(Pp[BASE + 0], Pp[BASE + 1]), cvtpk(Pp[BASE + 2], Pp[BASE + 3]), cvtpk(Pp[BASE + 4], Pp[BASE + 5]), cvtpk(Pp[BASE + 6], Pp[BASE + 7])}; OUT = __builtin_bit_cast(bf16x8, w); } while (0)
            PB(p0, 0, pb0); PB(p0, 8, pb1); PB(p1, 0, pb2); PB(p1, 8, pb3);
#undef PB
            if (__any(alpha < 1.f)) {
#pragma unroll
                for (int d = 0; d < 4; ++d)
#pragma unroll
                    for (int r = 0; r < 16; ++r) o[d][r] *= alpha;
            }
            SBAR();
            const int vb = vb0 + bf * ATT_VSZ;
            pv_one<0>(o[0], vb, pb0, pb1, pb2, pb3); pv_one<1>(o[1], vb, pb0, pb1, pb2, pb3); pv_one<2>(o[2], vb, pb0, pb1, pb2, pb3); pv_one<3>(o[3], vb, pb0, pb1, pb2, pb3);
        }
        if (j + 1 < jhi) { SWRITE(bf ^ 1); if (j + 2 < jhi) SLOAD(kstart + 64 * (j + 2)); }
        __syncthreads();
    }
#undef SLOAD
#undef SWRITE
    const float rl = __builtin_amdgcn_rcpf(l_reg);
    bf16_t* Ow = Qb + (tok0 + qpos) * 1024 + qh * 128 + (hi ? 8 : 0);
#pragma unroll
    for (int d0 = 0; d0 < 4; ++d0)
#pragma unroll
        for (int gp = 0; gp < 4; gp += 2) {
            unsigned ax = cvtpk(o[d0][4 * gp + 0] * rl, o[d0][4 * gp + 1] * rl), ay = cvtpk(o[d0][4 * gp + 2] * rl, o[d0][4 * gp + 3] * rl);
            unsigned bx = cvtpk(o[d0][4 * gp + 4] * rl, o[d0][4 * gp + 5] * rl), by = cvtpk(o[d0][4 * gp + 6] * rl, o[d0][4 * gp + 7] * rl);
            { auto r0 = __builtin_amdgcn_permlane32_swap(ax, bx, false, false); ax = r0[0]; bx = r0[1]; }
            { auto r1 = __builtin_amdgcn_permlane32_swap(ay, by, false, false); ay = r1[0]; by = r1[1]; }
            *(u32x4*)(Ow + d0 * 32 + gp * 8) = (u32x4){ax, ay, bx, by};
        }
}

constexpr int P5_SPART = 0, P5_LPART = 4096, P5_LOGIT = P5_LPART + 8 * 32 * 48 * 4, P5_HIST = P5_LOGIT + 32 * 48 * 4;
__device__ __forceinline__ void phase5(const Frame& F, const Params& P) {
    const float* y = (const float*)(P.ws + WS_E); bf16_t* x1b = (bf16_t*)(P.ws + WS_A);
    float* stat = (float*)(P.ws + WS_STAT); i32x2* list = (i32x2*)(P.ws + WS_LIST); int* cnt = (int*)(P.ws + WS_CTL) + CW_CNT;
    const bf16_t* wrh = (const bf16_t*)(P.ws + WS_WR); const bf16_t* wrl = wrh + 48 * 1024;
    LAS f32x2* spart = (LAS f32x2*)(F.lds + P5_SPART); LAS float* lpart = (LAS float*)(F.lds + P5_LPART); LAS float* logit = (LAS float*)(F.lds + P5_LOGIT);
    LAS int* hist = (LAS int*)(F.lds + P5_HIST); LAS int* hbase = hist + 32;
    const int lane = F.lane, w = F.wave, r16 = lane & 15, q4 = lane >> 4;
    const int colw = 128 * w + 8 * q4;
    bf16x8 bh[4][3], bl[4][3];
#pragma unroll
    for (int ks = 0; ks < 4; ++ks)
#pragma unroll
        for (int nb = 0; nb < 3; ++nb) { bh[ks][nb] = *(const bf16x8*)(wrh + (nb * 16 + r16) * 1024 + colw + 32 * ks); bl[ks][nb] = *(const bf16x8*)(wrl + (nb * 16 + r16) * 1024 + colw + 32 * ks); }
    for (int tile = F.bid; tile < M / 32; tile += F.G) {
        const int tok0 = tile * 32;
        f32x4 yv[2][4][2];
#pragma unroll
        for (int mb = 0; mb < 2; ++mb)
#pragma unroll
            for (int ks = 0; ks < 4; ++ks) { const float* p = y + (size_t)(tok0 + mb * 16 + r16) * 1024 + colw + 32 * ks; yv[mb][ks][0] = *(const f32x4*)p; yv[mb][ks][1] = *(const f32x4*)(p + 4); }
#pragma unroll
        for (int mb = 0; mb < 2; ++mb) { float s = 0.f, s2 = 0.f;
#pragma unroll
            for (int ks = 0; ks < 4; ++ks)
#pragma unroll
                for (int h = 0; h < 2; ++h) { const f32x4 v = yv[mb][ks][h]; s += (v.x + v.y) + (v.z + v.w); s2 += (v.x * v.x + v.y * v.y) + (v.z * v.z + v.w * v.w); }
            s += __shfl_xor(s, 16); s += __shfl_xor(s, 32); s2 += __shfl_xor(s2, 16); s2 += __shfl_xor(s2, 32);
            if (q4 == 0) spart[w * 32 + mb * 16 + r16] = (f32x2){s, s2}; }
        __syncthreads();
        f32x4 acc[2][3];
#pragma unroll
        for (int mb = 0; mb < 2; ++mb) {
            f32x2 t = {0.f, 0.f};
#pragma unroll
            for (int ww = 0; ww < 8; ++ww) t += spart[ww * 32 + mb * 16 + r16];
            const float mean = t.x * (1.f / 1024.f), var = t.y * (1.f / 1024.f) - mean * mean, rstd = 1.0f / sqrtf(fmaxf(var, 0.f) + LN_EPS);
            const size_t tok = (size_t)tok0 + mb * 16 + r16;
            if (w == 0 && q4 == 0) *(f32x2*)(stat + tok * 2) = (f32x2){mean, rstd};
#pragma unroll
            for (int nb = 0; nb < 3; ++nb) acc[mb][nb] = (f32x4){0.f, 0.f, 0.f, 0.f};
#pragma unroll
            for (int ks = 0; ks < 4; ++ks) {
                const int c0 = colw + 32 * ks;
                const f32x4 g0 = *(const f32x4*)(P.in[11] + c0), g1 = *(const f32x4*)(P.in[11] + c0 + 4), b0 = *(const f32x4*)(P.in[12] + c0), b1 = *(const f32x4*)(P.in[12] + c0 + 4);
                const f32x4 x0 = (yv[mb][ks][0] - mean) * rstd * g0 + b0, x1 = (yv[mb][ks][1] - mean) * rstd * g1 + b1;
                u32x4 hw = {cvtpk(x0.x, x0.y), cvtpk(x0.z, x0.w), cvtpk(x1.x, x1.y), cvtpk(x1.z, x1.w)};
                *(u32x4*)(x1b + tok * 1024 + c0) = hw;
                u32x4 lw = {cvtpk(x0.x - bflo(hw.x), x0.y - bfhi(hw.x)), cvtpk(x0.z - bflo(hw.y), x0.w - bfhi(hw.y)), cvtpk(x1.x - bflo(hw.z), x1.y - bfhi(hw.z)), cvtpk(x1.z - bflo(hw.w), x1.w - bfhi(hw.w))};
                const bf16x8 ah = __builtin_bit_cast(bf16x8, hw), al = __builtin_bit_cast(bf16x8, lw);
#pragma unroll
                for (int nb = 0; nb < 3; ++nb) {
                    acc[mb][nb] = __builtin_amdgcn_mfma_f32_16x16x32_bf16(ah, bh[ks][nb], acc[mb][nb], 0, 0, 0);
                    acc[mb][nb] = __builtin_amdgcn_mfma_f32_16x16x32_bf16(al, bh[ks][nb], acc[mb][nb], 0, 0, 0);
                    acc[mb][nb] = __builtin_amdgcn_mfma_f32_16x16x32_bf16(ah, bl[ks][nb], acc[mb][nb], 0, 0, 0);
                }
            }
#pragma unroll
            for (int nb = 0; nb < 3; ++nb)
#pragma unroll
                for (int r = 0; r < 4; ++r) lpart[(w * 32 + mb * 16 + 4 * q4 + r) * 48 + nb * 16 + r16] = acc[mb][nb][r];
        }
        __syncthreads();
#pragma unroll
        for (int i = 0; i < 3; ++i) { const int idx = F.tid + 512 * i; float sacc = 0.f;
#pragma unroll
            for (int ww = 0; ww < 8; ++ww) sacc += lpart[ww * 1536 + idx];
            logit[idx] = sacc; }
        __syncthreads();
        if (w == 0) {
            if (lane < 32) hist[lane] = 0;
            const int t = lane & 31; const int tok = tok0 + t; const LAS float* lg = logit + t * 48;
            const float* brg = P.in[14]; const float* bre = P.in[16];
            const float g0 = lg[0] + brg[0], g1 = lg[1] + brg[1], g2 = lg[2] + brg[2], g3 = lg[3] + brg[3];
            int gi = 0; float gm = g0; if (g1 > gm) { gm = g1; gi = 1; } if (g2 > gm) { gm = g2; gi = 2; } if (g3 > gm) { gm = g3; gi = 3; }
            const float gsum = __expf(g0 - gm) + __expf(g1 - gm) + __expf(g2 - gm) + __expf(g3 - gm);
            const float gw = 1.0f / gsum;
            float el[8];
#pragma unroll
            for (int i = 0; i < 8; ++i) el[i] = lg[4 + gi * 8 + i] + bre[gi * 8 + i];
            int i1 = 0; float m1 = el[0];
#pragma unroll
            for (int i = 1; i < 8; ++i) if (el[i] > m1) { m1 = el[i]; i1 = i; }
            int i2 = -1; float m2 = -3.0e38f;
#pragma unroll
            for (int i = 0; i < 8; ++i) if (i != i1 && el[i] > m2) { m2 = el[i]; i2 = i; }
            const float w1 = 1.0f / (1.0f + __expf(m2 - m1)), w2 = 1.0f - w1;
            const int e1 = gi * 8 + i1, e2 = gi * 8 + i2;
            asm volatile("s_waitcnt lgkmcnt(0)" ::: "memory");
            int lp1 = 0, lp2 = 0;
            if (lane < 32) { lp1 = __hip_atomic_fetch_add(hist + e1, 1, __ATOMIC_RELAXED, __HIP_MEMORY_SCOPE_WORKGROUP); lp2 = __hip_atomic_fetch_add(hist + e2, 1, __ATOMIC_RELAXED, __HIP_MEMORY_SCOPE_WORKGROUP); }
            asm volatile("s_waitcnt lgkmcnt(0)" ::: "memory");
            if (lane < 32) { const int c = hist[lane]; int base = 0; if (c > 0) base = atomicAdd(cnt + lane, c); hbase[lane] = base; }
            asm volatile("s_waitcnt vmcnt(0) lgkmcnt(0)" ::: "memory");
            if (lane < 32) {
                const int p1 = hbase[e1] + lp1, p2 = hbase[e2] + lp2;
                list[(size_t)e1 * CAP + p1] = (i32x2){tok * 2, (int)__float_as_uint(gw * w1)};
                list[(size_t)e2 * CAP + p2] = (i32x2){tok * 2 + 1, (int)__float_as_uint(gw * w2)};
            }
        }
        __syncthreads();
    }
}

__device__ __forceinline__ void p8_row(const Frame& F, const Params& P, int tok) {
    const float* y = (const float*)(P.ws + WS_E); const float* stat = (const float*)(P.ws + WS_STAT);
    const bf16_t* S0 = (const bf16_t*)(P.ws + WS_C); const bf16_t* S1 = (const bf16_t*)(P.ws + WS_D);
    const int lane = F.lane; const size_t base = (size_t)tok * 1024 + 4 * lane;
    const float mean = stat[tok * 2], rstd = stat[tok * 2 + 1];
    f32x4 z[4]; float s = 0.f;
#pragma unroll
    for (int j = 0; j < 4; ++j) {
        const f32x4 yv = *(const f32x4*)(y + base + 256 * j);
        const f32x4 g1 = *(const f32x4*)(P.in[11] + 4 * lane + 256 * j), b1 = *(const f32x4*)(P.in[12] + 4 * lane + 256 * j);
        const u32x2 a = *(const u32x2*)(S0 + base + 256 * j), b = *(const u32x2*)(S1 + base + 256 * j);
        const f32x4 x1 = (yv - mean) * rstd * g1 + b1;
        const f32x4 mo = (f32x4){bflo(a.x) + bflo(b.x), bfhi(a.x) + bfhi(b.x), bflo(a.y) + bflo(b.y), bfhi(a.y) + bfhi(b.y)};
        z[j] = x1 * ALPHA + mo; s += (z[j].x + z[j].y) + (z[j].z + z[j].w);
    }
    const float m2 = wave_sum(s) * (1.f / 1024.f); float q = 0.f;
#pragma unroll
    for (int j = 0; j < 4; ++j) { z[j] = z[j] - m2; q += (z[j].x * z[j].x + z[j].y * z[j].y) + (z[j].z * z[j].z + z[j].w * z[j].w); }
    const float r2 = 1.0f / sqrtf(wave_sum(q) * (1.f / 1024.f) + LN_EPS);
#pragma unroll
    for (int j = 0; j < 4; ++j) {
        const f32x4 g2 = *(const f32x4*)(P.in[19] + 4 * lane + 256 * j), b2 = *(const f32x4*)(P.in[20] + 4 * lane + 256 * j);
        *(f32x4*)(P.out + base + 256 * j) = z[j] * r2 * g2 + b2;
    }
}

__device__ __forceinline__ void moe_prefix(const Frame& F, const Params& P) {
    LAS int* pre = (LAS int*)(F.lds + LDS_PRE);
    const int* cnt = (const int*)(P.ws + WS_CTL) + CW_CNT;
    if (F.tid == 0) { int acc = 0; pre[0] = 0;
        for (int e = 0; e < NEXP; ++e) { const int n = cnt[e]; pre[33 + e] = n; acc += (n + 255) >> 8; pre[e + 1] = acc; } }
    __syncthreads();
}

__global__ void __launch_bounds__(NTHREADS, 2) fwd_kernel(Params P) {
    extern __shared__ __attribute__((aligned(16))) unsigned char lds_raw[];
    cg::grid_group grid = cg::this_grid();
    Frame F;
    F.lds = (LAS unsigned char*)lds_raw; F.tid = threadIdx.x; F.lane = F.tid & 63; F.wave = __builtin_amdgcn_readfirstlane(F.tid >> 6);
    F.G = gridDim.x; F.bid = blockIdx.x; F.in = P.in; F.out = P.out; F.ws = P.ws;
    unsigned char* ws = P.ws;
    const int lo = P.ph_lo, hi = P.ph_hi;
#ifndef PHASE_MASK
#define PHASE_MASK 0x1ff
#endif
#define IN(k) (((PHASE_MASK >> (k)) & 1) && lo <= (k) && (k) < hi)
#define SEAM(k) do { if (IN(k) && IN((k) + 1)) grid.sync(); } while (0)

    if (IN(0)) { phase0(F, P); }
    SEAM(0);
    if (IN(1)) {
        ProbIn p; p.ws = ws; p.G = F.G; p.c = F.bid; p.b_gate = P.in[2];
        pg8::gemm_phase<ProbIn, true>(F.lds, p);
    }
    SEAM(1);
    if (IN(2)) {
#ifndef P2_SKIP_ATTN
        for (int it = F.bid; it < NBATCH * 64 * 4; it += F.G) attn_item(F, P, it);
#endif
        __syncthreads();
#ifndef P2_SKIP_CONV
        for (int t = F.bid; t < M / 32; t += F.G) conv_tile(F, P, t);
#endif
    }
    SEAM(2);
    if (IN(3)) {
        ProbMix p; p.ws = ws; p.G = F.G; p.c = F.bid;
        pg8::gemm_phase<ProbMix, true>(F.lds, p);
    }
    SEAM(3);
    if (IN(4)) {
        ProbOut p; p.A = (const bf16_t*)(ws + WS_B); p.Bt = (const bf16_t*)(ws + WS_WO); p.G = F.G; p.c = F.bid; p.x = P.in[0]; p.y = (float*)(ws + WS_E);
        pg8::gemm_phase<ProbOut, true>(F.lds, p);
    }
    SEAM(4);
    if (IN(5)) {
        phase5(F, P);
    }
    SEAM(5);
    if (IN(6)) {
        moe_prefix(F, P);
        ProbMoe1 p; p.A = (const bf16_t*)(ws + WS_A); p.Bt = (const bf16_t*)(ws + WS_WGU); p.G = F.G; p.c = F.bid; p.pre = (const LAS int*)(F.lds + LDS_PRE);
        p.list = (const i32x2*)(ws + WS_LIST); p.Hm = (bf16_t*)(ws + WS_B);
        pg8::gemm_phase<ProbMoe1, true>(F.lds, p);
    }
    SEAM(6);
    if (IN(7)) {
        moe_prefix(F, P);
        ProbMoe2 p; p.A = (const bf16_t*)(ws + WS_B); p.Bt = (const bf16_t*)(ws + WS_WD); p.G = F.G; p.c = F.bid; p.pre = (const LAS int*)(F.lds + LDS_PRE);
        p.list = (const i32x2*)(ws + WS_LIST); p.S0 = (bf16_t*)(ws + WS_C); p.S1 = (bf16_t*)(ws + WS_D);
        pg8::gemm_phase<ProbMoe2, true>(F.lds, p);
    }
    SEAM(7);
    if (IN(8)) {
        for (int tok = F.bid * 8 + F.wave; tok < M; tok += F.G * 8) p8_row(F, P, tok);
    }
#undef IN
#undef SEAM
}

#ifndef MK_REPEAT_MASK
#define MK_REPEAT_MASK 0
#endif
#ifndef MK_ONE_LAUNCH
#define MK_ONE_LAUNCH 1
#endif
extern "C" void kernel_launch(void* const* d_in, const int* in_sizes, int n_in, void* d_out, int out_size, void* d_ws, size_t ws_size, hipStream_t stream) {
    static int grid = 0;
    if (grid == 0) {
        if (n_in != 21 || in_sizes[0] != M * D || out_size != M * D || ws_size < WS_END) {
            fprintf(stderr, "kernel_launch: unexpected shapes: n_in %d in0 %d out %d ws %zu (need >= %zu)\n", n_in, n_in > 0 ? in_sizes[0] : -1, out_size, ws_size, (size_t)WS_END);
            grid = -1; return; }
        int dev = 0, cus = 0, per_cu = 0;
        hipGetDevice(&dev); hipDeviceGetAttribute(&cus, hipDeviceAttributeMultiprocessorCount, dev);
        if (hipFuncSetAttribute((const void*)fwd_kernel, hipFuncAttributeMaxDynamicSharedMemorySize, LDS_BYTES) != hipSuccess) { fprintf(stderr, "kernel_launch: hipFuncSetAttribute failed\n"); grid = -1; return; }
        hipOccupancyMaxActiveBlocksPerMultiprocessor(&per_cu, (const void*)fwd_kernel, NTHREADS, LDS_BYTES);
        if (per_cu < 1) { fprintf(stderr, "kernel_launch: occupancy query says %d blocks per CU\n", per_cu); per_cu = 1; }
        (void)hipGetLastError();
        grid = cus;
    }
    if (grid < 0) return;
    Params p{};
    for (int i = 0; i < 21; ++i) p.in[i] = (const float*)d_in[i];
    p.out = (float*)d_out; p.ws = (unsigned char*)d_ws;
#if MK_ONE_LAUNCH
    p.ph_lo = 0; p.ph_hi = NPH;
    void* args[] = {&p};
    hipError_t e = hipLaunchCooperativeKernel((const void*)fwd_kernel, dim3(grid), dim3(NTHREADS), args, LDS_BYTES, stream);
    if (e != hipSuccess) fprintf(stderr, "kernel_launch: cooperative launch failed: %s (grid %d)\n", hipGetErrorString(e), grid);
#else
    for (int ph = 0; ph < NPH; ++ph) {
        p.ph_lo = ph; p.ph_hi = ph + 1;
        hipLaunchKernelGGL(fwd_kernel, dim3(grid), dim3(NTHREADS), LDS_BYTES, stream, p);
        if ((MK_REPEAT_MASK >> ph) & 1) hipLaunchKernelGGL(fwd_kernel, dim3(grid), dim3(NTHREADS), LDS_BYTES, stream, p);
    }
    hipError_t e = hipPeekAtLastError();
    if (e != hipSuccess) fprintf(stderr, "kernel_launch: launch failed: %s\n", hipGetErrorString(e));
#endif
}
```

```cpp
#include <hip/hip_runtime.h>
#include <hip/hip_cooperative_groups.h>
#include <cstdio>
#include <cstdint>
namespace cg = cooperative_groups;

#define LAS __attribute__((address_space(3)))
typedef unsigned short bf16_t;
typedef short bf16x8 __attribute__((ext_vector_type(8)));
typedef short s16x4 __attribute__((ext_vector_type(4)));
typedef float f32x2 __attribute__((ext_vector_type(2)));
typedef float f32x4 __attribute__((ext_vector_type(4)));
typedef float f32x8 __attribute__((ext_vector_type(8)));
typedef float f32x16 __attribute__((ext_vector_type(16)));
typedef unsigned u32x2 __attribute__((ext_vector_type(2)));
typedef unsigned u32x4 __attribute__((ext_vector_type(4)));
typedef __bf16 bf16x2_t __attribute__((ext_vector_type(2)));
typedef int i32x2 __attribute__((ext_vector_type(2)));

constexpr int D = 1024, NBATCH = 4, SEQ = 8192, M = NBATCH * SEQ;
constexpr int INW = 6144;
constexpr int NEXP = 32, EH = 256;
constexpr int CAP = 32768;
constexpr float LN_EPS = 1e-5f;
constexpr float ALPHA = 1.189207115002721f;
constexpr float LOG2E = 1.4426950408889634f;
constexpr int NTHREADS = 512;
constexpr int NPH = 9;

constexpr size_t MiB = 1u << 20;
constexpr size_t WS_CTL = 0;
constexpr size_t WS_WIN = 2 * MiB;
constexpr size_t WS_WC = 14 * MiB, WS_WA = 16 * MiB, WS_WO = 18 * MiB;
constexpr size_t WS_WGU = 20 * MiB;
constexpr size_t WS_WD = 52 * MiB;
constexpr size_t WS_WR = 68 * MiB;
constexpr size_t WS_TOKW = 69 * MiB;
constexpr size_t WS_STAT = 70 * MiB;
constexpr size_t WS_LIST = 71 * MiB;
constexpr size_t WS_A = 80 * MiB;
constexpr size_t WS_B = 144 * MiB;
constexpr size_t WS_C = 209 * MiB;
constexpr size_t WS_D = 273 * MiB;
constexpr size_t WS_E = 337 * MiB;
constexpr size_t WS_END = 465 * MiB;
constexpr int HPAD = 15, HROWS = SEQ + 2 * HPAD;
constexpr int CW_CNT = 0;
constexpr int CW_BAR = 4096;

constexpr int LDS_BYTES = 147456;
constexpr int LDS_PRE = 140288;
constexpr int LDS_MISC = 141312;

__device__ __forceinline__ unsigned cvtpk(float lo, float hi) { f32x2 v = {lo, hi}; bf16x2_t b = __builtin_convertvector(v, bf16x2_t); return __builtin_bit_cast(unsigned, b); }
__device__ __forceinline__ float bf2f(unsigned h) { return __uint_as_float(h << 16); }
__device__ __forceinline__ float bflo(unsigned w) { return __uint_as_float(w << 16); }
__device__ __forceinline__ float bfhi(unsigned w) { return __uint_as_float(w & 0xffff0000u); }
__device__ __forceinline__ float sigmoidf_(float x) { return __builtin_amdgcn_rcpf(1.0f + __builtin_amdgcn_exp2f(-x * LOG2E)); }
__device__ __forceinline__ float wave_sum(float v) {
#pragma unroll
    for (int o = 1; o < 64; o <<= 1) v += __shfl_xor(v, o);
    return v;
}

struct Params {
    const float* in[21];
    float* out;
    unsigned char* ws;
    int ph_lo, ph_hi;
};

namespace pg8 {
constexpr int BM = 256, BK = 64, HALF = 128, HTB = HALF * BK * 2, STAGE_BYTES = 8 * HTB, NXCD = 8, WGM = 8;
__host__ __device__ __forceinline__ int lds_byte(int r, int c) { const int st = (r >> 4) * 2 + (c >> 5), rr = r & 15, cc = c & 31, ob = rr * 64 + cc * 2; return st * 1024 + (ob ^ (((ob >> 9) & 1) << 5)); }
__host__ __device__ __forceinline__ void stage_rc(int b, int& R, int& C) { const int st = b / 1024, sb = b % 1024, swz = sb ^ (((sb >> 9) & 1) << 5); R = (st >> 1) * 16 + swz / 64; C = (st & 1) * 32 + (swz % 64) / 2; }
__host__ __device__ __forceinline__ int perm32(int rho) { const int n = rho >> 4, i = rho & 15; return 8 * (i >> 2) + 4 * n + (i & 3); }

struct Unit { int pm, pn, ex, lb, nv; };

__device__ __forceinline__ bool static_tile(int L, int nM, int nN, int& pm, int& pn) {
    const int nwg = nM * nN; if (L >= nwg) return false;
    int wgid = L; { const int q = nwg / NXCD, r = nwg % NXCD, xcd = wgid % NXCD, off = wgid / NXCD; wgid = (xcd < r ? xcd * (q + 1) : r * (q + 1) + (xcd - r) * q) + off; }
    const int nig = WGM * nN, gid = wgid / nig, fm = gid * WGM, gsz = (nM - fm) < WGM ? (nM - fm) : WGM;
    pm = fm + ((wgid % nig) % gsz); pn = (wgid % nig) / gsz; return true;
}

template <class P, bool ALIGN_EPI>
__device__ __forceinline__ void gemm_phase(LAS unsigned char* lds, const P& p) {
    constexpr int K = P::K; constexpr bool GATHER = P::GATHER;
    const int tid = threadIdx.x, wid = __builtin_amdgcn_readfirstlane(tid >> 6), lane = tid & 63, wr = wid >> 2, wc = wid & 3, fr = lane & 15, fq = lane >> 4;
    constexpr int nt = K / BK;
    unsigned voffB[2]; int Rr[2], Cc[2];
#pragma unroll
    for (int i = 0; i < 2; ++i) { int R, C; stage_rc(tid * 16 + i * 8192, R, C); const int Rb = (R & ~31) + perm32(R & 31); voffB[i] = (unsigned)(Rb * K + C) * 2u; Rr[i] = R; Cc[i] = C; }
    constexpr size_t kstep = (size_t)(BK * 2);
    constexpr size_t hstep = (size_t)HALF * K * 2;
    const unsigned ldsw = (unsigned)wid * 1024u;
    const int aoff = lds_byte(wr * 64 + fr, fq * 8), boff = lds_byte(wc * 32 + fr, fq * 8);
#define PG8_SA(b, h) (((b) * 2 + (h)) * HTB)
#define PG8_SB(b, h) ((4 + (b) * 2 + (h)) * HTB)
#define PG8_GL(src, dstoff) __builtin_amdgcn_global_load_lds((const unsigned*)(src), (LAS unsigned*)(lds + (dstoff)), 16, 0, 0)
#define PG8_STAGEB(bufoff, gbase) do { PG8_GL((const char*)(gbase) + voffB[0], (bufoff) + ldsw); PG8_GL((const char*)(gbase) + voffB[1], (bufoff) + ldsw + 8192); } while (0)
#define PG8_STAGEA(bufoff, gbase, v0, v1) do { PG8_GL((const char*)(gbase) + (v0), (bufoff) + ldsw); PG8_GL((const char*)(gbase) + (v1), (bufoff) + ldsw + 8192); } while (0)
#define PG8_LDA(dst, b, h) do { _Pragma("unroll") for (int m = 0; m < 4; ++m) _Pragma("unroll") for (int k = 0; k < 2; ++k) dst[m][k] = *(const LAS bf16x8*)(lds + PG8_SA(b, h) + aoff + m * 2048 + k * 1024); } while (0)
#define PG8_LDB(dst, b, h) do { _Pragma("unroll") for (int n = 0; n < 2; ++n) _Pragma("unroll") for (int k = 0; k < 2; ++k) dst[n][k] = *(const LAS bf16x8*)(lds + PG8_SB(b, h) + boff + n * 2048 + k * 1024); } while (0)
#define PG8_MMA(ai, bj, At, Bt) do { __builtin_amdgcn_s_setprio(1); _Pragma("unroll") for (int m = 0; m < 4; ++m) _Pragma("unroll") for (int n = 0; n < 2; ++n) _Pragma("unroll") for (int k = 0; k < 2; ++k) \
        acc[ai][bj][m][n] = __builtin_amdgcn_mfma_f32_16x16x32_bf16(Bt[n][k], At[m][k], acc[ai][bj][m][n], 0, 0, 0); __builtin_amdgcn_s_setprio(0); } while (0)
#define PG8_WAIT_V(n) asm volatile("s_waitcnt vmcnt(" #n ")" ::: "memory")
#define PG8_WAIT_L(n) asm volatile("s_waitcnt lgkmcnt(" #n ")" ::: "memory")
#define PG8_BAR __builtin_amdgcn_s_barrier()
#define PG8_SCHED __builtin_amdgcn_sched_barrier(0)
    Unit cur, nxt; int ui = 0;
    if (!p.next(0, cur)) return;
    f32x4 acc[2][2][4][2];
#pragma unroll
    for (int a = 0; a < 2; ++a)
#pragma unroll
        for (int b = 0; b < 2; ++b)
#pragma unroll
            for (int m = 0; m < 4; ++m)
#pragma unroll
                for (int n = 0; n < 2; ++n) acc[a][b][m][n] = (f32x4){0.f, 0.f, 0.f, 0.f};
    bf16x8 At[4][2], B0[2][2], B1[2][2];
    const char* cA = p.a_base(cur); const char* cB = p.b_base(cur);
    unsigned c00, c01, c10, c11;
    if constexpr (GATHER) { c00 = p.a_off(cur, Rr[0], Cc[0]); c01 = p.a_off(cur, Rr[1], Cc[1]); c10 = p.a_off(cur, Rr[0] + HALF, Cc[0]); c11 = p.a_off(cur, Rr[1] + HALF, Cc[1]); }
    else { c00 = (unsigned)(Rr[0] * K + Cc[0]) * 2u; c01 = (unsigned)(Rr[1] * K + Cc[1]) * 2u; c10 = c00 + (unsigned)hstep; c11 = c01 + (unsigned)hstep; }
    PG8_STAGEB(PG8_SB(0, 0), cB); PG8_STAGEB(PG8_SB(0, 1), cB + hstep); PG8_STAGEA(PG8_SA(0, 0), cA, c00, c01); PG8_STAGEA(PG8_SA(0, 1), cA, c10, c11);
    if (wr == 1) PG8_BAR;
    PG8_WAIT_V(2); PG8_BAR;
    PG8_STAGEB(PG8_SB(1, 0), cB + kstep); PG8_STAGEA(PG8_SA(1, 0), cA + kstep, c00, c01); PG8_STAGEB(PG8_SB(1, 1), cB + hstep + kstep);
    PG8_WAIT_V(6); PG8_BAR;
    for (;;) {
        const bool has_next = p.next(ui + 1, nxt);
        const char* nA = has_next ? p.a_base(nxt) : cA; const char* nB = has_next ? p.b_base(nxt) : cB;
        unsigned n00 = c00, n01 = c01, n10 = c10, n11 = c11;
        if constexpr (GATHER) { if (has_next) { n00 = p.a_off(nxt, Rr[0], Cc[0]); n01 = p.a_off(nxt, Rr[1], Cc[1]); n10 = p.a_off(nxt, Rr[0] + HALF, Cc[0]); n11 = p.a_off(nxt, Rr[1] + HALF, Cc[1]); } }
#pragma unroll 1
        for (int t = 0; t < nt; t += 2) {
            const bool last = (t == nt - 2);
            const char* a1 = cA + (size_t)(t + 1) * kstep;
            const char* a2 = last ? nA : cA + (size_t)(t + 2) * kstep; const char* b2 = last ? nB : cB + (size_t)(t + 2) * kstep;
            const char* a3 = a2 + kstep; const char* b3 = b2 + kstep;
            unsigned x00 = c00, x01 = c01, x10 = c10, x11 = c11;
            if constexpr (GATHER) { if (last) { x00 = n00; x01 = n01; x10 = n10; x11 = n11; } }
            PG8_LDB(B0, 0, 0); PG8_LDB(B1, 0, 1); PG8_SCHED; PG8_LDA(At, 0, 0); PG8_STAGEA(PG8_SA(1, 1), a1, c10, c11);
            PG8_WAIT_V(8); PG8_WAIT_L(0); PG8_BAR; PG8_MMA(0, 0, At, B0); PG8_MMA(0, 1, At, B1); PG8_BAR; PG8_SCHED;
            PG8_LDA(At, 0, 1); PG8_STAGEB(PG8_SB(0, 0), b2); PG8_STAGEB(PG8_SB(0, 1), b2 + hstep); PG8_STAGEA(PG8_SA(0, 0), a2, x00, x01);
            PG8_WAIT_V(8); PG8_WAIT_L(0); PG8_BAR; PG8_MMA(1, 0, At, B0); PG8_MMA(1, 1, At, B1); PG8_BAR; PG8_SCHED;
            PG8_LDB(B0, 1, 0); PG8_LDB(B1, 1, 1); PG8_SCHED; PG8_LDA(At, 1, 0); PG8_STAGEA(PG8_SA(0, 1), a2, x10, x11);
            PG8_WAIT_V(8); PG8_WAIT_L(0); PG8_BAR; PG8_MMA(0, 0, At, B0); PG8_MMA(0, 1, At, B1); PG8_BAR; PG8_SCHED;
            PG8_LDA(At, 1, 1); PG8_STAGEB(PG8_SB(1, 0), b3); PG8_STAGEB(PG8_SB(1, 1), b3 + hstep); PG8_STAGEA(PG8_SA(1, 0), a3, x00, x01);
            PG8_WAIT_V(8); PG8_WAIT_L(0); PG8_BAR; PG8_MMA(1, 0, At, B0); PG8_MMA(1, 1, At, B1); PG8_BAR; PG8_SCHED;
        }
        if constexpr (ALIGN_EPI) { if (wr == 0) PG8_BAR; }
        const bool keep = p.epi(acc, cur, wr, wc, fr, fq);
        if (!has_next) break;
        if (!keep) {
#pragma unroll
            for (int a = 0; a < 2; ++a)
#pragma unroll
                for (int b = 0; b < 2; ++b)
#pragma unroll
                    for (int m = 0; m < 4; ++m)
#pragma unroll
                        for (int n = 0; n < 2; ++n) acc[a][b][m][n] = (f32x4){0.f, 0.f, 0.f, 0.f};
        }
        cur = nxt; cA = nA; cB = nB; c00 = n00; c01 = n01; c10 = n10; c11 = n11; ++ui;
        if constexpr (ALIGN_EPI) { if (wr == 1) PG8_BAR; }
    }
    PG8_WAIT_V(0);
    if constexpr (!ALIGN_EPI) { if (wr == 0) PG8_BAR; }
    PG8_BAR;
#undef PG8_SA
#undef PG8_SB
#undef PG8_GL
#undef PG8_STAGEA
#undef PG8_STAGEB
#undef PG8_LDA
#undef PG8_LDB
#undef PG8_MMA
#undef PG8_WAIT_V
#undef PG8_WAIT_L
#undef PG8_BAR
#undef PG8_SCHED
}
}
using pg8::Unit;

__device__ __forceinline__ void st16_bf16(bf16_t* p, f32x4 v0, f32x4 v1) {
    u32x4 w; w.x = cvtpk(v0[0], v0[1]); w.y = cvtpk(v0[2], v0[3]); w.z = cvtpk(v1[0], v1[1]); w.w = cvtpk(v1[2], v1[3]);
    *(u32x4*)p = w;
}
__device__ __forceinline__ void ld8_bf16(const bf16_t* p, f32x4& v0, f32x4& v1) {
    const u32x4 w = *(const u32x4*)p;
    v0 = (f32x4){bflo(w.x), bfhi(w.x), bflo(w.y), bfhi(w.y)}; v1 = (f32x4){bflo(w.z), bfhi(w.z), bflo(w.w), bfhi(w.w)};
}

struct ProbIn {
    static constexpr int K = 1024; static constexpr bool GATHER = false;
    unsigned char* ws; int G, c; const float* b_gate;
    __device__ __forceinline__ bool next(int i, Unit& u) const { u.ex = 0; u.lb = 0; u.nv = 256; return pg8::static_tile(i * G + c, M / 256, INW / 256, u.pm, u.pn); }
    __device__ __forceinline__ const char* a_base(const Unit& u) const { return (const char*)(ws + WS_A) + (size_t)u.pm * 256 * K * 2; }
    __device__ __forceinline__ const char* b_base(const Unit& u) const { return (const char*)(ws + WS_WIN) + (size_t)u.pn * 256 * K * 2; }
    __device__ __forceinline__ bool epi(f32x4 (&acc)[2][2][4][2], const Unit& u, int wr, int wc, int fr, int fq) const {
        const int row0 = u.pm * 256 + wr * 64 + fr, cw = wc * 32 + 8 * fq;
        if (u.pn < 8) {
#pragma unroll
            for (int ai = 0; ai < 2; ++ai)
#pragma unroll
                for (int m = 0; m < 4; ++m) {
                    f32x4 h0, h1;
#pragma unroll
                    for (int e = 0; e < 4; ++e) { h0[e] = acc[ai][0][m][0][e] * sigmoidf_(acc[ai][1][m][0][e]); h1[e] = acc[ai][0][m][1][e] * sigmoidf_(acc[ai][1][m][1][e]); }
                    st16_bf16((bf16_t*)(ws + WS_B) + (size_t)(row0 + ai * 128 + m * 16 + 2 * HPAD * (u.pm >> 5) + HPAD) * 1024 + u.pn * 128 + cw, h0, h1);
                }
        } else if (u.pn < 16) {
            size_t boff; int ld, colt;
            if (u.pn < 12) { boff = WS_C; ld = 1024; colt = (u.pn - 8) * 256; } else if (u.pn < 14) { boff = WS_D; ld = 512; colt = (u.pn - 12) * 256; } else { boff = WS_D + (size_t)M * 512 * 2; ld = 512; colt = (u.pn - 14) * 256; }
            bf16_t* base = (bf16_t*)(ws + boff);
#pragma unroll
            for (int ai = 0; ai < 2; ++ai)
#pragma unroll
                for (int m = 0; m < 4; ++m)
#pragma unroll
                    for (int bj = 0; bj < 2; ++bj) st16_bf16(base + (size_t)(row0 + ai * 128 + m * 16) * ld + colt + bj * 128 + cw, acc[ai][bj][m][0], acc[ai][bj][m][1]);
        } else {
            const int colt = (u.pn - 16) * 256;
            f32x4 bv[2][2];
#pragma unroll
            for (int bj = 0; bj < 2; ++bj)
#pragma unroll
                for (int n = 0; n < 2; ++n) bv[bj][n] = *(const f32x4*)(b_gate + colt + bj * 128 + cw + 4 * n);
#pragma unroll
            for (int ai = 0; ai < 2; ++ai)
#pragma unroll
                for (int m = 0; m < 4; ++m)
#pragma unroll
                    for (int bj = 0; bj < 2; ++bj) {
                        f32x4 v0 = acc[ai][bj][m][0] + bv[bj][0], v1 = acc[ai][bj][m][1] + bv[bj][1];
#pragma unroll
                        for (int e = 0; e < 4; ++e) { v0[e] = sigmoidf_(v0[e]); v1[e] = sigmoidf_(v1[e]); }
                        st16_bf16((bf16_t*)(ws + WS_E) + (size_t)(row0 + ai * 128 + m * 16) * 2048 + colt + bj * 128 + cw, v0, v1);
                    }
        }
        return false;
    }
};

struct ProbMix {
    static constexpr int K = 1024; static constexpr bool GATHER = false;
    unsigned char* ws; int G, c;
    __device__ __forceinline__ bool next(int i, Unit& u) const { u.ex = i & 1; u.lb = 0; u.nv = 256; return pg8::static_tile((i >> 1) * G + c, M / 256, D / 256, u.pm, u.pn); }
    __device__ __forceinline__ const char* a_base(const Unit& u) const { return (const char*)(ws + (u.ex ? WS_C : WS_A)) + (size_t)u.pm * 256 * K * 2; }
    __device__ __forceinline__ const char* b_base(const Unit& u) const { return (const char*)(ws + (u.ex ? WS_WA : WS_WC)) + (size_t)u.pn * 256 * K * 2; }
    __device__ __forceinline__ bool epi(f32x4 (&acc)[2][2][4][2], const Unit& u, int wr, int wc, int fr, int fq) const {
        const int row0 = u.pm * 256 + wr * 64 + fr, col0 = u.pn * 256 + wc * 32 + 8 * fq;
        const bf16_t* Gt = (const bf16_t*)(ws + WS_E); bf16_t* Mx = (bf16_t*)(ws + WS_B);
        if (u.ex == 0) {
#pragma unroll
            for (int ai = 0; ai < 2; ++ai)
#pragma unroll
                for (int m = 0; m < 4; ++m)
#pragma unroll
                    for (int bj = 0; bj < 2; ++bj) {
                        const bf16_t* gp = Gt + (size_t)(row0 + ai * 128 + m * 16) * 2048 + col0 + bj * 128;
                        f32x4 c0, c1, a0, a1; ld8_bf16(gp, c0, c1); ld8_bf16(gp + 1024, a0, a1);
#pragma unroll
                        for (int e = 0; e < 4; ++e) { acc[ai][bj][m][0][e] *= c0[e] * __builtin_amdgcn_rcpf(a0[e]); acc[ai][bj][m][1][e] *= c1[e] * __builtin_amdgcn_rcpf(a1[e]); }
                    }
            return true;
        }
#pragma unroll
        for (int ai = 0; ai < 2; ++ai)
#pragma unroll
            for (int m = 0; m < 4; ++m)
#pragma unroll
                for (int bj = 0; bj < 2; ++bj) {
                    const size_t off = (size_t)(row0 + ai * 128 + m * 16);
                    f32x4 a0, a1; ld8_bf16(Gt + off * 2048 + 1024 + col0 + bj * 128, a0, a1);
                    st16_bf16(Mx + off * 1024 + col0 + bj * 128, acc[ai][bj][m][0] * a0, acc[ai][bj][m][1] * a1);
                }
        return false;
    }
};

struct ProbOut {
    static constexpr int K = 1024; static constexpr bool GATHER = false;
    const bf16_t *A, *Bt; int G, c;
    const float* x; float* y;
    __device__ __forceinline__ bool next(int i, Unit& u) const { u.ex = 0; u.lb = 0; u.nv = 256; return pg8::static_tile(i * G + c, M / 256, D / 256, u.pm, u.pn); }
    __device__ __forceinline__ const char* a_base(const Unit& u) const { return (const char*)(A + (size_t)u.pm * 256 * K); }
    __device__ __forceinline__ const char* b_base(const Unit& u) const { return (const char*)(Bt + (size_t)u.pn * 256 * K); }
    __device__ __forceinline__ bool epi(f32x4 (&acc)[2][2][4][2], const Unit& u, int wr, int wc, int fr, int fq) const {
        const int row0 = u.pm * 256 + wr * 64 + fr, col0 = u.pn * 256 + wc * 32 + 8 * fq;
#pragma unroll
        for (int ai = 0; ai < 2; ++ai)
#pragma unroll
            for (int m = 0; m < 4; ++m)
#pragma unroll
                for (int bj = 0; bj < 2; ++bj) {
                    const size_t off = (size_t)(row0 + ai * 128 + m * 16) * 1024 + col0 + bj * 128;
                    const f32x4 x0 = *(const f32x4*)(x + off), x1 = *(const f32x4*)(x + off + 4);
                    *(f32x4*)(y + off) = x0 * ALPHA + acc[ai][bj][m][0]; *(f32x4*)(y + off + 4) = x1 * ALPHA + acc[ai][bj][m][1];
                }
        return false;
    }
};

template <int NCOL>
__device__ __forceinline__ bool moe_next(const LAS int* pre, int L, Unit& u) {
    const int total = pre[NEXP] * NCOL; if (L >= total) return false;
    const int rtg = L / NCOL; u.pn = L - rtg * NCOL; int e = 0;
#pragma unroll 1
    for (int j = 1; j < NEXP; ++j) e += (pre[j] <= rtg) ? 1 : 0;
    e = __builtin_amdgcn_readfirstlane(e);
    const int rtl = rtg - pre[e], ne = pre[33 + e];
    u.pm = __builtin_amdgcn_readfirstlane(rtg); u.ex = e; u.lb = __builtin_amdgcn_readfirstlane(e * CAP + rtl * 256); u.nv = __builtin_amdgcn_readfirstlane(min(256, ne - rtl * 256));
    u.pn = __builtin_amdgcn_readfirstlane(u.pn);
    return true;
}
struct ProbMoe1 {
    static constexpr int K = 1024; static constexpr bool GATHER = true;
    const bf16_t *A, *Bt; int G, c; const LAS int* pre; const i32x2* list; bf16_t* Hm;
    __device__ __forceinline__ bool next(int i, Unit& u) const { return moe_next<2>(pre, i * G + c, u); }
    __device__ __forceinline__ const char* a_base(const Unit&) const { return (const char*)A; }
    __device__ __forceinline__ unsigned a_off(const Unit& u, int r, int cc) const { const int rr = r < u.nv ? r : u.nv - 1; const int ent = list[u.lb + rr].x; return (unsigned)((ent >> 1) * K + cc) * 2u; }
    __device__ __forceinline__ const char* b_base(const Unit& u) const { return (const char*)(Bt + ((size_t)u.ex * 512 + (size_t)u.pn * 256) * K); }
    __device__ __forceinline__ bool epi(f32x4 (&acc)[2][2][4][2], const Unit& u, int wr, int wc, int fr, int fq) const {
        const int row0 = u.pm * 256 + wr * 64 + fr, cw = u.pn * 128 + wc * 32 + 8 * fq;
#pragma unroll
        for (int ai = 0; ai < 2; ++ai)
#pragma unroll
            for (int m = 0; m < 4; ++m) {
                f32x4 h0, h1;
#pragma unroll
                for (int e = 0; e < 4; ++e) { const float g0 = acc[ai][0][m][0][e], g1 = acc[ai][0][m][1][e]; h0[e] = g0 * sigmoidf_(g0) * acc[ai][1][m][0][e]; h1[e] = g1 * sigmoidf_(g1) * acc[ai][1][m][1][e]; }
                st16_bf16(Hm + (size_t)(row0 + ai * 128 + m * 16) * EH + cw, h0, h1);
            }
        return false;
    }
};
struct ProbMoe2 {
    static constexpr int K = 256; static constexpr bool GATHER = false;
    const bf16_t *A, *Bt; int G, c; const LAS int* pre; const i32x2* list; bf16_t *S0, *S1;
    __device__ __forceinline__ bool next(int i, Unit& u) const { return moe_next<4>(pre, i * G + c, u); }
    __device__ __forceinline__ const char* a_base(const Unit& u) const { return (const char*)(A + (size_t)u.pm * 256 * K); }
    __device__ __forceinline__ const char* b_base(const Unit& u) const { return (const char*)(Bt + ((size_t)u.ex * 1024 + (size_t)u.pn * 256) * K); }
    __device__ __forceinline__ bool epi(f32x4 (&acc)[2][2][4][2], const Unit& u, int wr, int wc, int fr, int fq) const {
        const int col0 = u.pn * 256 + wc * 32 + 8 * fq;
        i32x2 ents[2][4];
#pragma unroll
        for (int ai = 0; ai < 2; ++ai)
#pragma unroll
            for (int m = 0; m < 4; ++m) { const int rl = ai * 128 + wr * 64 + m * 16 + fr; ents[ai][m] = (i32x2){-1, 0}; if (rl < u.nv) ents[ai][m] = list[u.lb + rl]; }
#pragma unroll
        for (int ai = 0; ai < 2; ++ai)
#pragma unroll
            for (int m = 0; m < 4; ++m) {
                const int ent = ents[ai][m].x;
                if (ent >= 0) {
                    const float w = __uint_as_float((unsigned)ents[ai][m].y);
                    bf16_t* dst = ((ent & 1) ? S1 : S0) + (size_t)(ent >> 1) * 1024 + col0;
#pragma unroll
                    for (int bj = 0; bj < 2; ++bj) st16_bf16(dst + bj * 128, acc[ai][bj][m][0] * w, acc[ai][bj][m][1] * w);
                }
            }
        return false;
    }
};

__device__ __forceinline__ int map_win(int n) { if (n < 1024) return (n >> 7) * 256 + (n & 127); if (n < 2048) { const int q = n - 1024; return (q >> 7) * 256 + 128 + (q & 127); } return n; }
__device__ __forceinline__ int map_gu(int n) { const int q = n & 255, up = n >> 8; return (q >> 7) * 256 + up * 128 + (q & 127); }
template <int MODE>
__device__ __forceinline__ void p0_transpose_item(const float* W, int K, int N, bf16_t* WT, LAS float* scr, int item, int lane) {
    const int nblk = N / 32, kb = item / nblk, nb = item % nblk, k0 = 64 * kb, n0 = 32 * nb;
#pragma unroll 8
    for (int i = 0; i < 32; ++i) { const int kk = 2 * i + (lane >> 5); scr[kk * 33 + (lane & 31)] = W[(size_t)(k0 + kk) * N + n0 + (lane & 31)]; }
    asm volatile("s_waitcnt lgkmcnt(0)" ::: "memory");
    const int c = lane & 7;
#pragma unroll
    for (int j = 0; j < 4; ++j) { const int n = (lane >> 3) + 8 * j; const LAS float* s = scr + (8 * c) * 33 + n;
        u32x4 o; o.x = cvtpk(s[0 * 33], s[1 * 33]); o.y = cvtpk(s[2 * 33], s[3 * 33]); o.z = cvtpk(s[4 * 33], s[5 * 33]); o.w = cvtpk(s[6 * 33], s[7 * 33]);
        const int nn = n0 + n; const int row = MODE == 1 ? map_win(nn) : (MODE == 2 ? map_gu(nn) : nn);
        *(u32x4*)(WT + (size_t)row * K + k0 + 8 * c) = o; }
    asm volatile("s_waitcnt lgkmcnt(0)" ::: "memory");
}

struct Frame {
    LAS unsigned char* lds;
    int tid, lane, wave, G, bid;
    const float* const* in;
    float* out; unsigned char* ws;
};

__device__ __forceinline__ void phase0(const Frame& F, const Params& P) {
    unsigned char* ws = P.ws;
    LAS float* scr = (LAS float*)(F.lds + F.wave * 16384);
    const int gw = F.bid * 8 + F.wave, NGW = F.G * 8;
    for (int i = F.bid * NTHREADS + F.tid; i < NBATCH * 2 * HPAD * 128; i += F.G * NTHREADS) {
        const int rr = i >> 7, c8 = (i & 127) * 8, b = rr / (2 * HPAD), q = rr % (2 * HPAD);
        const int hrow = b * HROWS + (q < HPAD ? q : SEQ + q);
        *(u32x4*)((bf16_t*)(ws + WS_B) + (size_t)hrow * 1024 + c8) = (u32x4){0u, 0u, 0u, 0u};
    }
    if (F.bid == 0) for (int i = F.tid; i < 3456; i += NTHREADS) ((unsigned*)(ws + WS_CTL))[CW_BAR + i] = 0u;
    if (F.bid == 0 && F.tid < NEXP) ((int*)(ws + WS_CTL))[CW_CNT + F.tid] = 0;
    constexpr int I_IN = 16 * (INW / 32), I_SQ = 16 * 32, I_GU = 16 * 16, I_DN = 4 * 32;
    constexpr int NITEMS = I_IN + 3 * I_SQ + NEXP * I_GU + NEXP * I_DN;
    for (int it = gw; it < NITEMS; it += NGW) {
        int r = it;
        if (r < I_IN) { p0_transpose_item<1>(P.in[1], D, INW, (bf16_t*)(ws + WS_WIN), scr, r, F.lane); continue; } r -= I_IN;
        if (r < I_SQ) { p0_transpose_item<0>(P.in[7], D, D, (bf16_t*)(ws + WS_WC), scr, r, F.lane); continue; } r -= I_SQ;
        if (r < I_SQ) { p0_transpose_item<0>(P.in[9], D, D, (bf16_t*)(ws + WS_WA), scr, r, F.lane); continue; } r -= I_SQ;
        if (r < I_SQ) { p0_transpose_item<0>(P.in[10], D, D, (bf16_t*)(ws + WS_WO), scr, r, F.lane); continue; } r -= I_SQ;
        if (r < NEXP * I_GU) { const int e = r / I_GU; p0_transpose_item<2>(P.in[17] + (size_t)e * D * 512, D, 512, (bf16_t*)(ws + WS_WGU) + (size_t)e * 512 * D, scr, r % I_GU, F.lane); continue; } r -= NEXP * I_GU;
        { const int e = r / I_DN; p0_transpose_item<0>(P.in[18] + (size_t)e * EH * D, EH, D, (bf16_t*)(ws + WS_WD) + (size_t)e * D * EH, scr, r % I_DN, F.lane); }
    }
    {
        bf16_t* wh = (bf16_t*)(ws + WS_WR); bf16_t* wl = wh + 48 * 1024;
        for (int idx = F.bid * NTHREADS + F.tid; idx < 48 * 1024; idx += F.G * NTHREADS) {
            const int col = idx >> 10, k = idx & 1023;
            float v = 0.f; if (col < 4) v = P.in[13][k * 4 + col]; else if (col < 36) v = P.in[15][k * 32 + (col - 4)];
            const unsigned h = cvtpk(v, 0.f) & 0xffffu; const float r = v - bf2f(h);
            wh[idx] = (bf16_t)h; wl[idx] = (bf16_t)(cvtpk(r, 0.f) & 0xffffu);
        }
    }
    {
        const float* x = P.in[0]; bf16_t* xb = (bf16_t*)(ws + WS_A);
        const size_t n8 = (size_t)M * D / 8;
        for (size_t i = (size_t)F.bid * NTHREADS + F.tid; i < n8; i += (size_t)F.G * NTHREADS) {
            const f32x4 a = *(const f32x4*)(x + i * 8), b = *(const f32x4*)(x + i * 8 + 4);
            st16_bf16(xb + i * 8, a, b);
        }
    }
}

template <int R, int T> struct ConvStep { static __device__ __forceinline__ void run(f32x2 (&acc)[32], const f32x2 (&w)[31], f32x2 xv) {
    constexpr int j = R - T; if constexpr (j >= 0 && j < 31) acc[T] += w[j] * xv; ConvStep<R, T + 1>::run(acc, w, xv); } };
template <int R> struct ConvStep<R, 32> { static __device__ __forceinline__ void run(f32x2 (&)[32], const f32x2 (&)[31], f32x2) {} };
template <int R> struct ConvRow { static __device__ __forceinline__ void run(f32x2 (&acc)[32], const f32x2 (&w)[31], const bf16_t* Hb) {
    const unsigned xw = *(const unsigned*)(Hb + (size_t)R * 1024); const f32x2 xv = {bflo(xw), bfhi(xw)};
    ConvStep<R, 0>::run(acc, w, xv); ConvRow<R + 1>::run(acc, w, Hb); } };
template <> struct ConvRow<62> { static __device__ __forceinline__ void run(f32x2 (&)[32], const f32x2 (&)[31], const bf16_t*) {} };
__device__ __forceinline__ void conv_tile(const Frame& F, const Params& P, int tile) {
    const bf16_t* H = (const bf16_t*)(P.ws + WS_B); bf16_t* hc = (bf16_t*)(P.ws + WS_A);
    const float* w_dw = P.in[3]; const float* b_dw = P.in[4]; const float* lg = P.in[5]; const float* lb = P.in[6];
    const int b = tile >> 8, t0 = (tile & 255) * 32, c2 = F.tid * 2;
    f32x2 acc[32];
    { const f32x2 bb = *(const f32x2*)(b_dw + c2);
#pragma unroll
      for (int t = 0; t < 32; ++t) acc[t] = bb; }
    f32x2 w[31];
#pragma unroll
    for (int j = 0; j < 31; ++j) w[j] = *(const f32x2*)(w_dw + j * 1024 + c2);
    const bf16_t* Hb = H + ((size_t)b * HROWS + t0) * 1024 + c2;
    ConvRow<0>::run(acc, w, Hb);
    LAS f32x2* red = (LAS f32x2*)F.lds;
#pragma unroll
    for (int t = 0; t < 32; ++t) red[t * 512 + F.tid] = (f32x2){acc[t].x + acc[t].y, acc[t].x * acc[t].x + acc[t].y * acc[t].y};
    __syncthreads();
    LAS f32x2* st = (LAS f32x2*)(F.lds + 131072);
#pragma unroll
    for (int q = 0; q < 4; ++q) { const int t = F.wave * 4 + q; f32x2 s = {0.f, 0.f};
#pragma unroll
        for (int i = 0; i < 8; ++i) { const f32x2 v = red[t * 512 + i * 64 + F.lane]; s += v; }
        const float s1 = wave_sum(s.x), s2 = wave_sum(s.y);
        const float mean = s1 * (1.f / 1024.f), var = s2 * (1.f / 1024.f) - mean * mean;
        if (F.lane == 0) st[t] = (f32x2){mean, 1.0f / sqrtf(fmaxf(var, 0.f) + LN_EPS)};
    }
    __syncthreads();
    const f32x2 gg = *(const f32x2*)(lg + c2), bb2 = *(const f32x2*)(lb + c2);
    bf16_t* ob = hc + ((size_t)b * SEQ + t0) * 1024 + c2;
#pragma unroll
    for (int t = 0; t < 32; ++t) { const f32x2 ms = st[t];
        const float v0 = (acc[t].x - ms.x) * ms.y * gg.x + bb2.x, v1 = (acc[t].y - ms.x) * ms.y * gg.y + bb2.y;
        *(unsigned*)(ob + (size_t)t * 1024) = cvtpk(v0 * sigmoidf_(v0), v1 * sigmoidf_(v1)); }
    __syncthreads();
}

#define KSWZ(row, colB) ((row) * 256 + ((colB) ^ (((row) & 7) << 4)))
#define SBAR() __builtin_amdgcn_sched_barrier(0)
constexpr int VPITCH = 320;
constexpr int ATT_KSZ = 64 * 256, ATT_VSZ = 64 * VPITCH, ATT_V0 = 2 * ATT_KSZ;
template <int OFF> __device__ __forceinline__ s16x4 tr_read(int vb) {
    s16x4 r; asm volatile("ds_read_b64_tr_b16 %0, %1 offset:%2" : "=&v"(r) : "v"(vb), "i"(OFF) : "memory"); return r;
}
template <int D0> __device__ __forceinline__ void pv_one(f32x16& od, int vb, bf16x8 pb0, bf16x8 pb1, bf16x8 pb2, bf16x8 pb3) {
#define VOFF(s, half) (D0 * 64 + (16 * (s) + 8 * (half)) * VPITCH)
    const s16x4 l0 = tr_read<VOFF(0, 0)>(vb), h0 = tr_read<VOFF(0, 1)>(vb), l1 = tr_read<VOFF(1, 0)>(vb), h1 = tr_read<VOFF(1, 1)>(vb);
    const s16x4 l2 = tr_read<VOFF(2, 0)>(vb), h2 = tr_read<VOFF(2, 1)>(vb), l3 = tr_read<VOFF(3, 0)>(vb), h3 = tr_read<VOFF(3, 1)>(vb);
#undef VOFF
    asm volatile("s_waitcnt lgkmcnt(0)" ::: "memory"); SBAR();
#define PK(L, Hh) (bf16x8){L[0], L[1], L[2], L[3], Hh[0], Hh[1], Hh[2], Hh[3]}
    od = __builtin_amdgcn_mfma_f32_32x32x16_bf16(PK(l0, h0), pb0, od, 0, 0, 0);
    od = __builtin_amdgcn_mfma_f32_32x32x16_bf16(PK(l1, h1), pb1, od, 0, 0, 0);
    od = __builtin_amdgcn_mfma_f32_32x32x16_bf16(PK(l2, h2), pb2, od, 0, 0, 0);
    od = __builtin_amdgcn_mfma_f32_32x32x16_bf16(PK(l3, h3), pb3, od, 0, 0, 0);
#undef PK
}

__device__ __forceinline__ void attn_item(const Frame& F, const Params& P, int item) {
    bf16_t* Qb = (bf16_t*)(P.ws + WS_C); const bf16_t* Kb = (const bf16_t*)(P.ws + WS_D); const bf16_t* Vb = Kb + (size_t)M * 512;
    const int hkv = item & 3, n = (item >> 2) & 63, b = item >> 8;
    const int wid = F.wave, lane = F.lane, r32 = lane & 31, hi = lane >> 5;
    const int g = wid >> 2, qh = hkv * 2 + g, qrow0 = (wid & 3) * 32;
    const size_t tok0 = (size_t)b * SEQ;
    const int qmin = n * 128 + qrow0, qpos = qmin + r32;
    char* lds = (char*)F.lds;
    bf16x8 qr[8];
    { const bf16_t* Qw = Qb + (tok0 + qpos) * 1024 + qh * 128 + hi * 8;
#pragma unroll
      for (int d0 = 0; d0 < 8; ++d0) qr[d0] = *(const bf16x8*)(Qw + d0 * 16); }
    constexpr float C = 0.08838834764831845f * LOG2E;
    const float slope2 = __builtin_amdgcn_exp2f(-(float)(qh + 1)) * LOG2E;
    const float nbias = -slope2 * (1.0f / C);
    float m_reg = P.in[8][qh] * LOG2E, l_reg = 1.0f;
    f32x16 o[4];
#pragma unroll
    for (int d = 0; d < 4; ++d)
#pragma unroll
        for (int r = 0; r < 16; ++r) o[d][r] = 0.f;
    const int jlo = (n == 0) ? 2 : 0, jhi = (n == 63) ? 4 : 6;
    const int kstart = n * 128 - 128;
    const int sr = F.tid >> 4, sc = (F.tid & 15) * 8;
    const int kst0 = KSWZ(sr, sc * 2), kst1 = KSWZ(32 + sr, sc * 2), vst0 = ATT_V0 + sr * VPITCH + sc * 2, vst1 = ATT_V0 + (32 + sr) * VPITCH + sc * 2;
    const int vb0 = (int)(uintptr_t)(lds + ATT_V0) + (4 * hi + ((lane & 15) >> 2)) * VPITCH + (16 * ((lane >> 4) & 1) + 4 * (lane & 3)) * 2;
    const bf16_t* Kg = Kb + tok0 * 512 + hkv * 128 + sc; const bf16_t* Vg = Vb + tok0 * 512 + hkv * 128 + sc;
    bf16x8 vs0, vs1, ks0, ks1;
#define SLOAD(k0) do { vs0 = *(const bf16x8*)(Vg + (size_t)((k0) + sr) * 512); vs1 = *(const bf16x8*)(Vg + (size_t)((k0) + 32 + sr) * 512); \
        ks0 = *(const bf16x8*)(Kg + (size_t)((k0) + sr) * 512); ks1 = *(const bf16x8*)(Kg + (size_t)((k0) + 32 + sr) * 512); } while (0)
#define SWRITE(bf) do { *(bf16x8*)(lds + (bf) * ATT_KSZ + kst0) = ks0; *(bf16x8*)(lds + (bf) * ATT_KSZ + kst1) = ks1; \
        *(bf16x8*)(lds + (bf) * ATT_VSZ + vst0) = vs0; *(bf16x8*)(lds + (bf) * ATT_VSZ + vst1) = vs1; } while (0)
    SLOAD(kstart + 64 * jlo);
    SWRITE(0);
    SLOAD(kstart + 64 * (jlo + 1));
    __syncthreads();
    for (int j = jlo; j < jhi; ++j) {
        const int bf = (j - jlo) & 1;
        const int kp0 = kstart + 64 * j;
        if (kp0 + 63 >= qmin - 128 && kp0 <= qmin + 31 + 128) {
            const char* Kl = lds + bf * ATT_KSZ;
            const int rel0 = kp0 + 4 * hi - qpos;
            f32x16 p0, p1;
            const bool full = (kp0 >= qmin + 31 - 128) && (kp0 + 63 <= qmin + 128);
            if (full) {
#pragma unroll
                for (int r = 0; r < 16; ++r) { const int cofs = (r & 3) + 8 * (r >> 2);
                    p0[r] = nbias * fabsf((float)(rel0 + cofs)); p1[r] = nbias * fabsf((float)(rel0 + cofs + 32)); }
            } else {
#pragma unroll
                for (int r = 0; r < 16; ++r) { const int cofs = (r & 3) + 8 * (r >> 2);
                    const float d0f = fabsf((float)(rel0 + cofs)), d1f = fabsf((float)(rel0 + cofs + 32));
                    p0[r] = d0f > 128.f ? -1e30f : nbias * d0f; p1[r] = d1f > 128.f ? -1e30f : nbias * d1f; }
            }
#pragma unroll
            for (int d0 = 0; d0 < 8; ++d0) { const int cb = (d0 * 16 + hi * 8) * 2;
                const bf16x8 b0 = *(const bf16x8*)(Kl + KSWZ(r32, cb));
                const bf16x8 b1 = *(const bf16x8*)(Kl + KSWZ(32 + r32, cb));
                p0 = __builtin_amdgcn_mfma_f32_32x32x16_bf16(b0, qr[d0], p0, 0, 0, 0);
                p1 = __builtin_amdgcn_mfma_f32_32x32x16_bf16(b1, qr[d0], p1, 0, 0, 0); }
            float pmax = fmaxf(p0[0], p1[0]);
#pragma unroll
            for (int r = 1; r < 16; ++r) pmax = fmaxf(pmax, fmaxf(p0[r], p1[r]));
            { auto rr = __builtin_amdgcn_permlane32_swap(__float_as_uint(pmax), __float_as_uint(pmax), false, false);
              pmax = fmaxf(__uint_as_float(rr[0]), __uint_as_float(rr[1])); }
            const float mn = fmaxf(m_reg, pmax * C), alpha = __builtin_amdgcn_exp2f(m_reg - mn); m_reg = mn;
            float ps = 0.f;
#pragma unroll
            for (int r = 0; r < 16; ++r) { p0[r] = __builtin_amdgcn_exp2f(fmaf(p0[r], C, -mn)); p1[r] = __builtin_amdgcn_exp2f(fmaf(p1[r], C, -mn)); ps += p0[r] + p1[r]; }
            { auto rr = __builtin_amdgcn_permlane32_swap(__float_as_uint(ps), __float_as_uint(ps), false, false);
              ps = __uint_as_float(rr[0]) + __uint_as_float(rr[1]); }
            l_reg = l_reg * alpha + ps;
            bf16x8 pb0, pb1, pb2, pb3;
#define PB(Pp, BASE, OUT) do { u32x4 w = {cvtpk(Pp[BASE + 0], Pp[BASE + 1]), cvtpk(Pp[BASE + 2], Pp[BASE + 3]), cvtpk(Pp[BASE + 4], Pp[BASE + 5]), cvtpk(Pp[BASE + 6], Pp[BASE + 7])}; OUT = __builtin_bit_cast(bf16x8, w); } while (0)
            PB(p0, 0, pb0); PB(p0, 8, pb1); PB(p1, 0, pb2); PB(p1, 8, pb3);
#undef PB
            if (__any(alpha < 1.f)) {
#pragma unroll
                for (int d = 0; d < 4; ++d)
#pragma unroll
                    for (int r = 0; r < 16; ++r) o[d][r] *= alpha;
            }
            SBAR();
            const int vb = vb0 + bf * ATT_VSZ;
            pv_one<0>(o[0], vb, pb0, pb1, pb2, pb3); pv_one<1>(o[1], vb, pb0, pb1, pb2, pb3); pv_one<2>(o[2], vb, pb0, pb1, pb2, pb3); pv_one<3>(o[3], vb, pb0, pb1, pb2, pb3);
        }
        if (j + 1 < jhi) { SWRITE(bf ^ 1); if (j + 2 < jhi) SLOAD(kstart + 64 * (j + 2)); }
        __syncthreads();
    }
#undef SLOAD
#undef SWRITE
    const float rl = __builtin_amdgcn_rcpf(l_reg);
    bf16_t* Ow = Qb + (tok0 + qpos) * 1024 + qh * 128 + (hi ? 8 : 0);
#pragma unroll
    for (int d0 = 0; d0 < 4; ++d0)
#pragma unroll
        for (int gp = 0; gp < 4; gp += 2) {
            unsigned ax = cvtpk(o[d0][4 * gp + 0] * rl, o[d0][4 * gp + 1] * rl), ay = cvtpk(o[d0][4 * gp + 2] * rl, o[d0][4 * gp + 3] * rl);
            unsigned bx = cvtpk(o[d0][4 * gp + 4] * rl, o[d0][4 * gp + 5] * rl), by = cvtpk(o[d0][4 * gp + 6] * rl, o[d0][4 * gp + 7] * rl);
            { auto r0 = __builtin_amdgcn_permlane32_swap(ax, bx, false, false); ax = r0[0]; bx = r0[1]; }
            { auto r1 = __builtin_amdgcn_permlane32_swap(ay, by, false, false); ay = r1[0]; by = r1[1]; }
            *(u32x4*)(Ow + d0 * 32 + gp * 8) = (u32x4){ax, ay, bx, by};
        }
}

constexpr int P5_SPART = 0, P5_LPART = 4096, P5_LOGIT = P5_LPART + 8 * 32 * 48 * 4, P5_HIST = P5_LOGIT + 32 * 48 * 4;
__device__ __forceinline__ void phase5(const Frame& F, const Params& P) {
    const float* y = (const float*)(P.ws + WS_E); bf16_t* x1b = (bf16_t*)(P.ws + WS_A);
    float* stat = (float*)(P.ws + WS_STAT); i32x2* list = (i32x2*)(P.ws + WS_LIST); int* cnt = (int*)(P.ws + WS_CTL) + CW_CNT;
    const bf16_t* wrh = (const bf16_t*)(P.ws + WS_WR); const bf16_t* wrl = wrh + 48 * 1024;
    LAS f32x2* spart = (LAS f32x2*)(F.lds + P5_SPART); LAS float* lpart = (LAS float*)(F.lds + P5_LPART); LAS float* logit = (LAS float*)(F.lds + P5_LOGIT);
    LAS int* hist = (LAS int*)(F.lds + P5_HIST); LAS int* hbase = hist + 32;
    const int lane = F.lane, w = F.wave, r16 = lane & 15, q4 = lane >> 4;
    const int colw = 128 * w + 8 * q4;
    bf16x8 bh[4][3], bl[4][3];
#pragma unroll
    for (int ks = 0; ks < 4; ++ks)
#pragma unroll
        for (int nb = 0; nb < 3; ++nb) { bh[ks][nb] = *(const bf16x8*)(wrh + (nb * 16 + r16) * 1024 + colw + 32 * ks); bl[ks][nb] = *(const bf16x8*)(wrl + (nb * 16 + r16) * 1024 + colw + 32 * ks); }
    for (int tile = F.bid; tile < M / 32; tile += F.G) {
        const int tok0 = tile * 32;
        f32x4 yv[2][4][2];
#pragma unroll
        for (int mb = 0; mb < 2; ++mb)
#pragma unroll
            for (int ks = 0; ks < 4; ++ks) { const float* p = y + (size_t)(tok0 + mb * 16 + r16) * 1024 + colw + 32 * ks; yv[mb][ks][0] = *(const f32x4*)p; yv[mb][ks][1] = *(const f32x4*)(p + 4); }
#pragma unroll
        for (int mb = 0; mb < 2; ++mb) { float s = 0.f, s2 = 0.f;
#pragma unroll
            for (int ks = 0; ks < 4; ++ks)
#pragma unroll
                for (int h = 0; h < 2; ++h) { const f32x4 v = yv[mb][ks][h]; s += (v.x + v.y) + (v.z + v.w); s2 += (v.x * v.x + v.y * v.y) + (v.z * v.z + v.w * v.w); }
            s += __shfl_xor(s, 16); s += __shfl_xor(s, 32); s2 += __shfl_xor(s2, 16); s2 += __shfl_xor(s2, 32);
            if (q4 == 0) spart[w * 32 + mb * 16 + r16] = (f32x2){s, s2}; }
        __syncthreads();
        f32x4 acc[2][3];
#pragma unroll
        for (int mb = 0; mb < 2; ++mb) {
            f32x2 t = {0.f, 0.f};
#pragma unroll
            for (int ww = 0; ww < 8; ++ww) t += spart[ww * 32 + mb * 16 + r16];
            const float mean = t.x * (1.f / 1024.f), var = t.y * (1.f / 1024.f) - mean * mean, rstd = 1.0f / sqrtf(fmaxf(var, 0.f) + LN_EPS);
            const size_t tok = (size_t)tok0 + mb * 16 + r16;
            if (w == 0 && q4 == 0) *(f32x2*)(stat + tok * 2) = (f32x2){mean, rstd};
#pragma unroll
            for (int nb = 0; nb < 3; ++nb) acc[mb][nb] = (f32x4){0.f, 0.f, 0.f, 0.f};
#pragma unroll
            for (int ks = 0; ks < 4; ++ks) {
                const int c0 = colw + 32 * ks;
                const f32x4 g0 = *(const f32x4*)(P.in[11] + c0), g1 = *(const f32x4*)(P.in[11] + c0 + 4), b0 = *(const f32x4*)(P.in[12] + c0), b1 = *(const f32x4*)(P.in[12] + c0 + 4);
                const f32x4 x0 = (yv[mb][ks][0] - mean) * rstd * g0 + b0, x1 = (yv[mb][ks][1] - mean) * rstd * g1 + b1;
                u32x4 hw = {cvtpk(x0.x, x0.y), cvtpk(x0.z, x0.w), cvtpk(x1.x, x1.y), cvtpk(x1.z, x1.w)};
                *(u32x4*)(x1b + tok * 1024 + c0) = hw;
                u32x4 lw = {cvtpk(x0.x - bflo(hw.x), x0.y - bfhi(hw.x)), cvtpk(x0.z - bflo(hw.y), x0.w - bfhi(hw.y)), cvtpk(x1.x - bflo(hw.z), x1.y - bfhi(hw.z)), cvtpk(x1.z - bflo(hw.w), x1.w - bfhi(hw.w))};
                const bf16x8 ah = __builtin_bit_cast(bf16x8, hw), al = __builtin_bit_cast(bf16x8, lw);
#pragma unroll
                for (int nb = 0; nb < 3; ++nb) {
                    acc[mb][nb] = __builtin_amdgcn_mfma_f32_16x16x32_bf16(ah, bh[ks][nb], acc[mb][nb], 0, 0, 0);
                    acc[mb][nb] = __builtin_amdgcn_mfma_f32_16x16x32_bf16(al, bh[ks][nb], acc[mb][nb], 0, 0, 0);
                    acc[mb][nb] = __builtin_amdgcn_mfma_f32_16x16x32_bf16(ah, bl[ks][nb], acc[mb][nb], 0, 0, 0);
                }
            }
#pragma unroll
            for (int nb = 0; nb < 3; ++nb)
#pragma unroll
                for (int r = 0; r < 4; ++r) lpart[(w * 32 + mb * 16 + 4 * q4 + r) * 48 + nb * 16 + r16] = acc[mb][nb][r];
        }
        __syncthreads();
#pragma unroll
        for (int i = 0; i < 3; ++i) { const int idx = F.tid + 512 * i; float sacc = 0.f;
#pragma unroll
            for (int ww = 0; ww < 8; ++ww) sacc += lpart[ww * 1536 + idx];
            logit[idx] = sacc; }
        __syncthreads();
        if (w == 0) {
            if (lane < 32) hist[lane] = 0;
            const int t = lane & 31; const int tok = tok0 + t; const LAS float* lg = logit + t * 48;
            const float* brg = P.in[14]; const float* bre = P.in[16];
            const float g0 = lg[0] + brg[0], g1 = lg[1] + brg[1], g2 = lg[2] + brg[2], g3 = lg[3] + brg[3];
            int gi = 0; float gm = g0; if (g1 > gm) { gm = g1; gi = 1; } if (g2 > gm) { gm = g2; gi = 2; } if (g3 > gm) { gm = g3; gi = 3; }
            const float gsum = __expf(g0 - gm) + __expf(g1 - gm) + __expf(g2 - gm) + __expf(g3 - gm);
            const float gw = 1.0f / gsum;
            float el[8];
#pragma unroll
            for (int i = 0; i < 8; ++i) el[i] = lg[4 + gi * 8 + i] + bre[gi * 8 + i];
            int i1 = 0; float m1 = el[0];
#pragma unroll
            for (int i = 1; i < 8; ++i) if (el[i] > m1) { m1 = el[i]; i1 = i; }
            int i2 = -1; float m2 = -3.0e38f;
#pragma unroll
            for (int i = 0; i < 8; ++i) if (i != i1 && el[i] > m2) { m2 = el[i]; i2 = i; }
            const float w1 = 1.0f / (1.0f + __expf(m2 - m1)), w2 = 1.0f - w1;
            const int e1 = gi * 8 + i1, e2 = gi * 8 + i2;
            asm volatile("s_waitcnt lgkmcnt(0)" ::: "memory");
            int lp1 = 0, lp2 = 0;
            if (lane < 32) { lp1 = __hip_atomic_fetch_add(hist + e1, 1, __ATOMIC_RELAXED, __HIP_MEMORY_SCOPE_WORKGROUP); lp2 = __hip_atomic_fetch_add(hist + e2, 1, __ATOMIC_RELAXED, __HIP_MEMORY_SCOPE_WORKGROUP); }
            asm volatile("s_waitcnt lgkmcnt(0)" ::: "memory");
            if (lane < 32) { const int c = hist[lane]; int base = 0; if (c > 0) base = atomicAdd(cnt + lane, c); hbase[lane] = base; }
            asm volatile("s_waitcnt vmcnt(0) lgkmcnt(0)" ::: "memory");
            if (lane < 32) {
                const int p1 = hbase[e1] + lp1, p2 = hbase[e2] + lp2;
                list[(size_t)e1 * CAP + p1] = (i32x2){tok * 2, (int)__float_as_uint(gw * w1)};
                list[(size_t)e2 * CAP + p2] = (i32x2){tok * 2 + 1, (int)__float_as_uint(gw * w2)};
            }
        }
        __syncthreads();
    }
}

__device__ __forceinline__ void p8_row(const Frame& F, const Params& P, int tok) {
    const float* y = (const float*)(P.ws + WS_E); const float* stat = (const float*)(P.ws + WS_STAT);
    const bf16_t* S0 = (const bf16_t*)(P.ws + WS_C); const bf16_t* S1 = (const bf16_t*)(P.ws + WS_D);
    const int lane = F.lane; const size_t base = (size_t)tok * 1024 + 4 * lane;
    const float mean = stat[tok * 2], rstd = stat[tok * 2 + 1];
    f32x4 z[4]; float s = 0.f;
#pragma unroll
    for (int j = 0; j < 4; ++j) {
        const f32x4 yv = *(const f32x4*)(y + base + 256 * j);
        const f32x4 g1 = *(const f32x4*)(P.in[11] + 4 * lane + 256 * j), b1 = *(const f32x4*)(P.in[12] + 4 * lane + 256 * j);
        const u32x2 a = *(const u32x2*)(S0 + base + 256 * j), b = *(const u32x2*)(S1 + base + 256 * j);
        const f32x4 x1 = (yv - mean) * rstd * g1 + b1;
        const f32x4 mo = (f32x4){bflo(a.x) + bflo(b.x), bfhi(a.x) + bfhi(b.x), bflo(a.y) + bflo(b.y), bfhi(a.y) + bfhi(b.y)};
        z[j] = x1 * ALPHA + mo; s += (z[j].x + z[j].y) + (z[j].z + z[j].w);
    }
    const float m2 = wave_sum(s) * (1.f / 1024.f); float q = 0.f;
#pragma unroll
    for (int j = 0; j < 4; ++j) { z[j] = z[j] - m2; q += (z[j].x * z[j].x + z[j].y * z[j].y) + (z[j].z * z[j].z + z[j].w * z[j].w); }
    const float r2 = 1.0f / sqrtf(wave_sum(q) * (1.f / 1024.f) + LN_EPS);
#pragma unroll
    for (int j = 0; j < 4; ++j) {
        const f32x4 g2 = *(const f32x4*)(P.in[19] + 4 * lane + 256 * j), b2 = *(const f32x4*)(P.in[20] + 4 * lane + 256 * j);
        *(f32x4*)(P.out + base + 256 * j) = z[j] * r2 * g2 + b2;
    }
}

__device__ __forceinline__ void moe_prefix(const Frame& F, const Params& P) {
    LAS int* pre = (LAS int*)(F.lds + LDS_PRE);
    const int* cnt = (const int*)(P.ws + WS_CTL) + CW_CNT;
    if (F.tid == 0) { int acc = 0; pre[0] = 0;
        for (int e = 0; e < NEXP; ++e) { const int n = cnt[e]; pre[33 + e] = n; acc += (n + 255) >> 8; pre[e + 1] = acc; } }
    __syncthreads();
}

#define XB_TMO      128
#define XB_XCNT(j)  (256  + 64 * (j))
#define XB_XSUB(j)  (1280 + 64 * (j))
#define XB_XGEN(j)  (2304 + 64 * (j))
#define XB_TOP      3328
#define XB_TOPGEN   3392
#define XCD_BAR_WORDS 3456
#define XB_SPIN_CAP (1u << 18)
__device__ __forceinline__ unsigned xb_ld(unsigned* p)              { return __hip_atomic_load(p, __ATOMIC_RELAXED, __HIP_MEMORY_SCOPE_AGENT); }
__device__ __forceinline__ unsigned xb_add(unsigned* p, unsigned v) { return __hip_atomic_fetch_add(p, v, __ATOMIC_RELAXED, __HIP_MEMORY_SCOPE_AGENT); }
__device__ __forceinline__ unsigned xb_xcc_id() { return (unsigned)__builtin_amdgcn_s_getreg((3 << 11) | 20) & 0xFu; }
#define XB_SPIN(cond, bar) do { unsigned _sp = 0; while (cond) { __builtin_amdgcn_s_sleep(1); \
    if ((++_sp & 255u) == 0u) { if (xb_ld(&(bar)[XB_TMO])) break; if (_sp > XB_SPIN_CAP) { atomicAdd(&(bar)[XB_TMO], 1u); break; } } } } while (0)
struct XcdBarrier { unsigned* bar; unsigned x; volatile LAS unsigned* st; };
__device__ __forceinline__ XcdBarrier xcd_barrier_post(unsigned* bar, volatile LAS unsigned* st) {
    XcdBarrier b; b.bar = bar; b.x = xb_xcc_id(); b.st = st;
    if (threadIdx.x == 0) (void)xb_add(&bar[XB_XCNT(b.x)], 1u);
    return b;
}
__device__ __forceinline__ void xcd_barrier_complete(unsigned* bar, unsigned x, unsigned& nloc, unsigned& nx) {
    const unsigned G = gridDim.x * gridDim.y * gridDim.z;
    unsigned sum, cnt, mine, sp = 0u;
    for (;;) {
        sum = 0u; cnt = 0u; mine = 0u;
#pragma unroll
        for (unsigned j = 0; j < 16; ++j) { const unsigned c = xb_ld(&bar[XB_XCNT(j)]); sum += c; cnt += (c > 0u) ? 1u : 0u; mine = (j == x) ? c : mine; }
        if (sum == G) break;
        __builtin_amdgcn_s_sleep(1);
        if ((++sp & 255u) == 0u) { if (xb_ld(&bar[XB_TMO])) break; if (sp > XB_SPIN_CAP) { atomicAdd(&bar[XB_TMO], 1u); break; } }
    }
    nloc = mine > 0u ? mine : 1u; nx = cnt > 0u ? cnt : 1u;
}
__device__ __forceinline__ void xcd_barrier(const XcdBarrier& b) {
    asm volatile("s_waitcnt vmcnt(0)" ::: "memory");
    __syncthreads();
    if (threadIdx.x == 0) {
        unsigned* bar = b.bar;
        __builtin_amdgcn_s_waitcnt(0);
        unsigned nloc = b.st[0], nx = b.st[1];
        if (nloc == 0u) { xcd_barrier_complete(bar, b.x, nloc, nx); b.st[0] = nloc; b.st[1] = nx; }
        const unsigned old = xb_add(&bar[XB_XSUB(b.x)], 1u);
        const unsigned gen = old / nloc;
        if (old + 1u == (gen + 1u) * nloc) {
            __builtin_amdgcn_fence(__ATOMIC_RELEASE, "agent");
            asm volatile("s_waitcnt vmcnt(0)" ::: "memory");
            const unsigned og = xb_add(&bar[XB_TOP], 1u);
            const unsigned tg = og / nx;
            if (og + 1u == (tg + 1u) * nx) xb_add(&bar[XB_TOPGEN], 1u);
            else XB_SPIN(xb_ld(&bar[XB_TOPGEN]) == tg, bar);
            __builtin_amdgcn_fence(__ATOMIC_ACQUIRE, "agent");
            xb_add(&bar[XB_XGEN(b.x)], 1u);
            asm volatile("s_waitcnt vmcnt(0)" ::: "memory");
        } else {
            XB_SPIN(xb_ld(&bar[XB_XGEN(b.x)]) == gen, bar);
            __builtin_amdgcn_fence(__ATOMIC_ACQUIRE, "agent");
            asm volatile("s_waitcnt vmcnt(0)" ::: "memory");
        }
    }
    __syncthreads();
}

__global__ void __launch_bounds__(NTHREADS, 2) fwd_kernel(Params P) {
    extern __shared__ __attribute__((aligned(16))) unsigned char lds_raw[];
    cg::grid_group grid = cg::this_grid();
    Frame F;
    F.lds = (LAS unsigned char*)lds_raw; F.tid = threadIdx.x; F.lane = F.tid & 63; F.wave = __builtin_amdgcn_readfirstlane(F.tid >> 6);
    F.G = gridDim.x; F.bid = blockIdx.x; F.in = P.in; F.out = P.out; F.ws = P.ws;
    unsigned char* ws = P.ws;
    const int lo = P.ph_lo, hi = P.ph_hi;
#ifndef PHASE_MASK
#define PHASE_MASK 0x1ff
#endif
#define IN(k) (((PHASE_MASK >> (k)) & 1) && lo <= (k) && (k) < hi)
    volatile LAS unsigned* misc = (volatile LAS unsigned*)(F.lds + LDS_MISC);
    if (F.tid < 2) misc[F.tid] = 0u;
    __syncthreads();
    XcdBarrier xbar; xbar.bar = (unsigned*)(ws + WS_CTL) + CW_BAR; xbar.x = 0; xbar.st = misc;
#define SEAM(k) do { if (IN(k) && IN((k) + 1)) { if ((k) == 0) { grid.sync(); xbar = xcd_barrier_post((unsigned*)(ws + WS_CTL) + CW_BAR, misc); } else xcd_barrier(xbar); } } while (0)

    if (IN(0)) { phase0(F, P); }
    SEAM(0);
    if (IN(1)) {
        ProbIn p; p.ws = ws; p.G = F.G; p.c = F.bid; p.b_gate = P.in[2];
        pg8::gemm_phase<ProbIn, true>(F.lds, p);
    }
    SEAM(1);
    if (IN(2)) {
#ifndef P2_SKIP_ATTN
        for (int it = F.bid; it < NBATCH * 64 * 4; it += F.G) attn_item(F, P, it);
#endif
        __syncthreads();
#ifndef P2_SKIP_CONV
        for (int t = F.bid; t < M / 32; t += F.G) conv_tile(F, P, t);
#endif
    }
    SEAM(2);
    if (IN(3)) {
        ProbMix p; p.ws = ws; p.G = F.G; p.c = F.bid;
        pg8::gemm_phase<ProbMix, true>(F.lds, p);
    }
    SEAM(3);
    if (IN(4)) {
        ProbOut p; p.A = (const bf16_t*)(ws + WS_B); p.Bt = (const bf16_t*)(ws + WS_WO); p.G = F.G; p.c = F.bid; p.x = P.in[0]; p.y = (float*)(ws + WS_E);
        pg8::gemm_phase<ProbOut, true>(F.lds, p);
    }
    SEAM(4);
    if (IN(5)) {
        phase5(F, P);
    }
    SEAM(5);
    if (IN(6)) {
        moe_prefix(F, P);
        ProbMoe1 p; p.A = (const bf16_t*)(ws + WS_A); p.Bt = (const bf16_t*)(ws + WS_WGU); p.G = F.G; p.c = F.bid; p.pre = (const LAS int*)(F.lds + LDS_PRE);
        p.list = (const i32x2*)(ws + WS_LIST); p.Hm = (bf16_t*)(ws + WS_B);
        pg8::gemm_phase<ProbMoe1, true>(F.lds, p);
    }
    SEAM(6);
    if (IN(7)) {
        moe_prefix(F, P);
        ProbMoe2 p; p.A = (const bf16_t*)(ws + WS_B); p.Bt = (const bf16_t*)(ws + WS_WD); p.G = F.G; p.c = F.bid; p.pre = (const LAS int*)(F.lds + LDS_PRE);
        p.list = (const i32x2*)(ws + WS_LIST); p.S0 = (bf16_t*)(ws + WS_C); p.S1 = (bf16_t*)(ws + WS_D);
        pg8::gemm_phase<ProbMoe2, true>(F.lds, p);
    }
    SEAM(7);
    if (IN(8)) {
        for (int tok = F.bid * 8 + F.wave; tok < M; tok += F.G * 8) p8_row(F, P, tok);
    }
#undef IN
#undef SEAM
}

#ifndef MK_REPEAT_MASK
#define MK_REPEAT_MASK 0
#endif
#ifndef MK_ONE_LAUNCH
#define MK_ONE_LAUNCH 1
#endif
extern "C" void kernel_launch(void* const* d_in, const int* in_sizes, int n_in, void* d_out, int out_size, void* d_ws, size_t ws_size, hipStream_t stream) {
    static int grid = 0;
    if (grid == 0) {
        if (n_in != 21 || in_sizes[0] != M * D || out_size != M * D || ws_size < WS_END) {
            fprintf(stderr, "kernel_launch: unexpected shapes: n_in %d in0 %d out %d ws %zu (need >= %zu)\n", n_in, n_in > 0 ? in_sizes[0] : -1, out_size, ws_size, (size_t)WS_END);
            grid = -1; return; }
        int dev = 0, cus = 0, per_cu = 0;
        hipGetDevice(&dev); hipDeviceGetAttribute(&cus, hipDeviceAttributeMultiprocessorCount, dev);
        if (hipFuncSetAttribute((const void*)fwd_kernel, hipFuncAttributeMaxDynamicSharedMemorySize, LDS_BYTES) != hipSuccess) { fprintf(stderr, "kernel_launch: hipFuncSetAttribute failed\n"); grid = -1; return; }
        hipOccupancyMaxActiveBlocksPerMultiprocessor(&per_cu, (const void*)fwd_kernel, NTHREADS, LDS_BYTES);
        if (per_cu < 1) { fprintf(stderr, "kernel_launch: occupancy query says %d blocks per CU\n", per_cu); per_cu = 1; }
        (void)hipGetLastError();
        grid = cus;
    }
    if (grid < 0) return;
    Params p{};
    for (int i = 0; i < 21; ++i) p.in[i] = (const float*)d_in[i];
    p.out = (float*)d_out; p.ws = (unsigned char*)d_ws;
#if MK_ONE_LAUNCH
    p.ph_lo = 0; p.ph_hi = NPH;
    void* args[] = {&p};
    hipError_t e = hipLaunchCooperativeKernel((const void*)fwd_kernel, dim3(grid), dim3(NTHREADS), args, LDS_BYTES, stream);
    if (e != hipSuccess) fprintf(stderr, "kernel_launch: cooperative launch failed: %s (grid %d)\n", hipGetErrorString(e), grid);
#else
    for (int ph = 0; ph < NPH; ++ph) {
        p.ph_lo = ph; p.ph_hi = ph + 1;
        hipLaunchKernelGGL(fwd_kernel, dim3(grid), dim3(NTHREADS), LDS_BYTES, stream, p);
        if ((MK_REPEAT_MASK >> ph) & 1) hipLaunchKernelGGL(fwd_kernel, dim3(grid), dim3(NTHREADS), LDS_BYTES, stream, p);
    }
    hipError_t e = hipPeekAtLastError();
    if (e != hipSuccess) fprintf(stderr, "kernel_launch: launch failed: %s\n", hipGetErrorString(e));
#endif
}
```
